# Optimizing an MI355X kernel written in HIP

```python
import jax, jax.numpy as jnp
from jax import lax
import numpy as np

D_MODEL = 1024
BATCH = 2
SEQ = 8192
DEPTH = 2

N_MEM = 256
HEAD_DIM = 64
ROT_DIM = HEAD_DIM // 4
ROPE_THETA = 500000.0
MEM_HEADS = 4
MEM_WIDTH = MEM_HEADS * HEAD_DIM
MIX_WIDTH = D_MODEL
PRIMARY_WIDTH = MIX_WIDTH - MEM_WIDTH
NSA_HEADS = PRIMARY_WIDTH // HEAD_DIM
NSA_KV_GROUPS = 3
NSA_GROUP_SIZE = NSA_HEADS // NSA_KV_GROUPS
NSA_KV_WIDTH = NSA_KV_GROUPS * HEAD_DIM
CMP_BLOCK = 32
CMP_STRIDE = 16
CMP_HIDDEN = 256
SEL_BLOCK = 64
SEL_TOPK = 16
WINDOW = 512
Q_BLOCK = 64
NSA_IN = PRIMARY_WIDTH + 6 * NSA_KV_WIDTH + 3 * NSA_HEADS + MEM_WIDTH
RWKV_HEADS = PRIMARY_WIDTH // HEAD_DIM
DECAY_LORA = 64
AAA_LORA = 64
GATE_LORA = 128
RWKV_SHIFT_W = 3 * PRIMARY_WIDTH + DECAY_LORA + AAA_LORA + GATE_LORA
RWKV_IN = RWKV_SHIFT_W + MEM_WIDTH
RWKV_GN_EPS = HEAD_DIM * 1e-5
FFN_HIDDEN = ((8 * D_MODEL + 3 * 256 - 1) // (3 * 256)) * 256
NORM_EPS = 1e-6
NEG = -1e30
FORCE = 1e6

kernel_name = 'hybrid_nsa_rwkv7_memory_trunk'


def rmsnorm(x, g):
    xf = x.astype(jnp.float32)
    y = xf * lax.rsqrt(jnp.mean(xf * xf, axis=-1, keepdims=True) + NORM_EPS)
    return (y * g.astype(jnp.float32)).astype(x.dtype)


def masked_softmax(s, mask):
    s = jnp.where(mask, s.astype(jnp.float32), NEG)
    m = jnp.max(s, axis=-1, keepdims=True)
    e = jnp.where(mask, jnp.exp(s - m), 0.0)
    return e / jnp.maximum(jnp.sum(e, axis=-1, keepdims=True), 1e-30)


def rope_tables(positions):
    inv = ROPE_THETA ** (-jnp.arange(0, ROT_DIM, 2, dtype=jnp.float32) / ROT_DIM)
    ang = positions.astype(jnp.float32)[..., None] * inv
    return jnp.cos(ang), jnp.sin(ang)


def apply_rope(t, cos, sin):
    half = ROT_DIM // 2
    c = cos[:, :, None, :].astype(t.dtype)
    s = sin[:, :, None, :].astype(t.dtype)
    t1, t2, rest = t[..., :half], t[..., half:ROT_DIM], t[..., ROT_DIM:]
    return jnp.concatenate([t1 * c - t2 * s, t1 * s + t2 * c, rest], axis=-1)


def nsa_mixer(proj, cos, sin, gate_b, cmp_pos_k, cmp_pos_v, cmp_k_w1, cmp_k_w2, cmp_v_w1, cmp_v_w2):
    B, S, _ = proj.shape
    G, Hg, Dh = NSA_KV_GROUPS, NSA_GROUP_SIZE, HEAD_DIM
    offs = list(np.cumsum([PRIMARY_WIDTH] + [NSA_KV_WIDTH] * 6)[:])
    q, kc_raw, vc_raw, ks, vs, kw, vw, gl = jnp.split(proj, offs, axis=-1)
    q = apply_rope(q.reshape(B, S, NSA_HEADS, Dh), cos, sin).reshape(B, S, G, Hg, Dh)
    ks = apply_rope(ks.reshape(B, S, G, Dh), cos, sin)
    kw = apply_rope(kw.reshape(B, S, G, Dh), cos, sin)
    vs = vs.reshape(B, S, G, Dh)
    vw = vw.reshape(B, S, G, Dh)
    gates = jax.nn.sigmoid(gl + gate_b).reshape(B, S, G, Hg, 3)

    n_cmp = (S - CMP_BLOCK) // CMP_STRIDE + 1
    cmp_idx = jnp.arange(n_cmp)[:, None] * CMP_STRIDE + jnp.arange(CMP_BLOCK)[None, :]
    cmp_end = cmp_idx[:, -1]

    def compress(t, pos_emb, w1, w2):
        blocks = t.reshape(B, S, G, Dh)[:, cmp_idx] + pos_emb[None, None, :, None, :]
        h = jax.nn.gelu(jnp.einsum('bnlgd,ldh->bngh', blocks, w1.reshape(CMP_BLOCK, Dh, CMP_HIDDEN)))
        return jnp.einsum('bngh,he->bnge', h, w2)

    kc = compress(kc_raw, cmp_pos_k, cmp_k_w1, cmp_k_w2)
    kc = apply_rope(kc, cos[:, cmp_end], sin[:, cmp_end])
    vc = compress(vc_raw, cmp_pos_v, cmp_v_w1, cmp_v_w2)

    n_sel = S // SEL_BLOCK
    n_topk = min(SEL_TOPK, n_sel)
    ksb = ks.reshape(B, n_sel, SEL_BLOCK, G, Dh).transpose(0, 3, 1, 2, 4)
    vsb = vs.reshape(B, n_sel, SEL_BLOCK, G, Dh).transpose(0, 3, 1, 2, 4)
    ratio = SEL_BLOCK // CMP_STRIDE
    pad_l = (CMP_BLOCK - CMP_STRIDE) // CMP_STRIDE
    n_taps = ratio + CMP_BLOCK // CMP_STRIDE - 1
    tap_w = jnp.asarray(np.array([
        max(0, min((o - pad_l) * CMP_STRIDE + CMP_BLOCK, SEL_BLOCK) - max((o - pad_l) * CMP_STRIDE, 0)) / CMP_STRIDE
        for o in range(n_taps)], dtype=np.float32))
    pad_r = ratio * (n_sel - 1) + n_taps - n_cmp - pad_l
    tap_idx = ratio * jnp.arange(n_sel)[:, None] + jnp.arange(n_taps)[None, :]

    kw_pad = jnp.pad(kw, ((0, 0), (WINDOW, 0), (0, 0), (0, 0)))
    vw_pad = jnp.pad(vw, ((0, 0), (WINDOW, 0), (0, 0), (0, 0)))

    n_qb = S // Q_BLOCK
    qb_all = q.reshape(B, n_qb, Q_BLOCK, G, Hg, Dh).swapaxes(0, 1)
    gb_all = gates.reshape(B, n_qb, Q_BLOCK, G, Hg, 3).swapaxes(0, 1)
    scale = HEAD_DIM ** -0.5
    b_idx = jnp.arange(B)[:, None, None, None]
    g_idx = jnp.arange(G)[None, :, None, None]
    jj = jnp.arange(n_sel)

    def block(args):
        qb, gb, blk = args
        t0 = blk * Q_BLOCK
        tq = t0 + jnp.arange(Q_BLOCK)
        s_c = jnp.einsum('bqghd,bngd->bghqn', qb, kc) * scale
        p_c = masked_softmax(s_c, cmp_end[None, :] <= tq[:, None])
        o_c = jnp.einsum('bghqn,bngd->bqghd', p_c.astype(vc.dtype), vc)
        imp = jnp.pad(p_c.sum(axis=2), ((0, 0), (0, 0), (0, 0), (pad_l, pad_r)))
        imp = jnp.einsum('bgqjt,t->bgqj', imp[..., tap_idx], tap_w)
        cur = tq // SEL_BLOCK
        forced = (jj[None, :] == 0) | (jj[None, :] == cur[:, None]) | (jj[None, :] == cur[:, None] - 1)
        score = jnp.where(forced, FORCE, imp)
        score = jnp.where(jj[None, :] <= cur[:, None], score, -FORCE)
        _, top = lax.top_k(score, n_topk)
        k_sel = ksb[b_idx, g_idx, top]
        v_sel = vsb[b_idx, g_idx, top]
        tok = top[..., None] * SEL_BLOCK + jnp.arange(SEL_BLOCK)
        m_s = (tok <= tq[:, None, None]).reshape(B, G, 1, Q_BLOCK, n_topk * SEL_BLOCK)
        s_s = jnp.einsum('bqghd,bgqkld->bghqkl', qb, k_sel).reshape(B, G, Hg, Q_BLOCK, n_topk * SEL_BLOCK) * scale
        p_s = masked_softmax(s_s, m_s).reshape(B, G, Hg, Q_BLOCK, n_topk, SEL_BLOCK)
        o_s = jnp.einsum('bghqkl,bgqkld->bqghd', p_s.astype(v_sel.dtype), v_sel)
        kwb = lax.dynamic_slice_in_dim(kw_pad, t0, Q_BLOCK + WINDOW, axis=1)
        vwb = lax.dynamic_slice_in_dim(vw_pad, t0, Q_BLOCK + WINDOW, axis=1)
        tk = t0 - WINDOW + jnp.arange(Q_BLOCK + WINDOW)
        m_w = (tk[None, :] <= tq[:, None]) & (tq[:, None] - tk[None, :] < WINDOW) & (tk[None, :] >= 0)
        s_w = jnp.einsum('bqghd,bkgd->bghqk', qb, kwb) * scale
        p_w = masked_softmax(s_w, m_w)
        o_w = jnp.einsum('bghqk,bkgd->bqghd', p_w.astype(vwb.dtype), vwb)
        out = gb[..., 0:1] * o_c + gb[..., 1:2] * o_s + gb[..., 2:3] * o_w
        return out.reshape(B, Q_BLOCK, PRIMARY_WIDTH)

    out = lax.map(block, (qb_all, gb_all, jnp.arange(n_qb)))
    return out.swapaxes(0, 1).reshape(B, S, PRIMARY_WIDTH)


def rwkv7_time_mix(proj, mu, w0, w2, a0, a2, g2, k_k, k_a, r_k, ln_g, ln_b):
    B, S, _ = proj.shape
    H, N = RWKV_HEADS, HEAD_DIM
    prev = jnp.pad(proj, ((0, 0), (1, 0), (0, 0)))[:, :-1]
    xs = proj + (prev - proj) * mu
    offs = list(np.cumsum([PRIMARY_WIDTH] * 3 + [DECAY_LORA, AAA_LORA]))
    r, k, v, wl, al, gl = jnp.split(xs, offs, axis=-1)
    w = -jax.nn.softplus(-(w0 + jnp.tanh(wl) @ w2)) - 0.5
    decay = jnp.exp(-jnp.exp(w.astype(jnp.float32)))
    a = jax.nn.sigmoid(a0 + al @ a2)
    g = jax.nn.sigmoid(gl) @ g2
    kk = (k * k_k).reshape(B, S, H, N).astype(jnp.float32)
    kk = kk * lax.rsqrt(jnp.maximum(jnp.sum(kk * kk, axis=-1, keepdims=True), 1e-24))
    k = k * (1.0 + (a - 1.0) * k_a)
    heads = lambda t: t.reshape(B, S, H, N).astype(jnp.float32)
    rh, kh, vh, ah = heads(r), heads(k), heads(v), heads(a)
    wh = decay.reshape(B, S, H, N)
    tmaj = lambda t: jnp.moveaxis(t, 1, 0)

    def step(state, inp):
        r_t, w_t, k_t, v_t, a_t, b_t = inp
        sa = jnp.einsum('bhij,bhj->bhi', state, a_t)
        state = state * w_t[:, :, None, :] + sa[..., None] * b_t[:, :, None, :] + v_t[..., None] * k_t[:, :, None, :]
        return state, jnp.einsum('bhij,bhj->bhi', state, r_t)

    s0 = jnp.zeros((B, H, N, N), jnp.float32)
    _, y = lax.scan(step, s0, (tmaj(rh), tmaj(wh), tmaj(kh), tmaj(vh), tmaj(-kk), tmaj(kk * ah)))
    y = jnp.moveaxis(y, 0, 1)
    mean = jnp.mean(y, axis=-1, keepdims=True)
    var = jnp.mean(jnp.square(y - mean), axis=-1, keepdims=True)
    y = ((y - mean) * lax.rsqrt(var + RWKV_GN_EPS)).reshape(B, S, PRIMARY_WIDTH) * ln_g + ln_b
    bonus = jnp.sum(rh * kh * r_k, axis=-1, keepdims=True) * vh
    y = y + bonus.reshape(B, S, PRIMARY_WIDTH)
    return (y * g).astype(proj.dtype)


def memory_attention(q_mem, mem_k, mem_v):
    B, S, _ = q_mem.shape
    q = q_mem.reshape(B, S, MEM_HEADS, HEAD_DIM)
    s = jnp.einsum('bshd,bmhd->bhsm', q, mem_k).astype(jnp.float32) * (HEAD_DIM ** -0.5)
    p = jax.nn.softmax(s, axis=-1)
    return jnp.einsum('bhsm,bmhd->bshd', p.astype(mem_v.dtype), mem_v).reshape(B, S, MEM_WIDTH)


def setup_inputs(seed: int = 0) -> dict:
    key = jax.random.key(seed)
    keys = iter(jax.random.split(key, 48))
    nrm = lambda shape, scale: jax.random.normal(next(keys), shape, jnp.float32) * scale
    gain = lambda shape: 1.0 + nrm(shape, 0.05)
    n_nsa = (DEPTH + 1) // 2
    n_rwkv = DEPTH // 2
    D = D_MODEL
    x = nrm((BATCH, SEQ, D), 1.0)
    mem = nrm((BATCH, N_MEM, D), 1.0)
    positions = jax.random.randint(next(keys), (BATCH, 1), 0, 4096, dtype=jnp.int32) + jnp.arange(SEQ, dtype=jnp.int32)[None, :]
    return {
        'x': x,
        'mem': mem,
        'positions': positions,
        'mem_norm_g': gain((D,)),
        'w_mem_kv': nrm((D, 2 * MEM_WIDTH), D ** -0.5),
        'pre_mix_g': gain((DEPTH, D)),
        'post_mix_g': gain((DEPTH, D)),
        'pre_ffn_g': gain((DEPTH, D)),
        'post_ffn_g': gain((DEPTH, D)),
        'w_out': nrm((DEPTH, MIX_WIDTH, D), MIX_WIDTH ** -0.5),
        'w_ffn_in': nrm((DEPTH, D, 2 * FFN_HIDDEN), D ** -0.5),
        'w_ffn_out': nrm((DEPTH, FFN_HIDDEN, D), FFN_HIDDEN ** -0.5),
        'nsa_w_in': nrm((n_nsa, D, NSA_IN), D ** -0.5),
        'nsa_gate_b': nrm((n_nsa, 3 * NSA_HEADS), 0.1),
        'nsa_cmp_pos_k': nrm((n_nsa, CMP_BLOCK, HEAD_DIM), 0.02),
        'nsa_cmp_pos_v': nrm((n_nsa, CMP_BLOCK, HEAD_DIM), 0.02),
        'nsa_cmp_k_w1': nrm((n_nsa, CMP_BLOCK * HEAD_DIM, CMP_HIDDEN), (CMP_BLOCK * HEAD_DIM) ** -0.5),
        'nsa_cmp_k_w2': nrm((n_nsa, CMP_HIDDEN, HEAD_DIM), CMP_HIDDEN ** -0.5),
        'nsa_cmp_v_w1': nrm((n_nsa, CMP_BLOCK * HEAD_DIM, CMP_HIDDEN), (CMP_BLOCK * HEAD_DIM) ** -0.5),
        'nsa_cmp_v_w2': nrm((n_nsa, CMP_HIDDEN, HEAD_DIM), CMP_HIDDEN ** -0.5),
        'rwkv_w_in': nrm((n_rwkv, D, RWKV_IN), D ** -0.5),
        'rwkv_mu': jax.random.uniform(next(keys), (n_rwkv, RWKV_SHIFT_W), jnp.float32),
        'rwkv_w0': jax.random.uniform(next(keys), (n_rwkv, PRIMARY_WIDTH), jnp.float32, -5.0, -0.5),
        'rwkv_w2': nrm((n_rwkv, DECAY_LORA, PRIMARY_WIDTH), 0.5 * DECAY_LORA ** -0.5),
        'rwkv_a0': nrm((n_rwkv, PRIMARY_WIDTH), 0.5),
        'rwkv_a2': nrm((n_rwkv, AAA_LORA, PRIMARY_WIDTH), AAA_LORA ** -0.5),
        'rwkv_g2': nrm((n_rwkv, GATE_LORA, PRIMARY_WIDTH), GATE_LORA ** -0.5),
        'rwkv_k_k': 0.85 + nrm((n_rwkv, PRIMARY_WIDTH), 0.05),
        'rwkv_k_a': gain((n_rwkv, PRIMARY_WIDTH)),
        'rwkv_r_k': nrm((n_rwkv, RWKV_HEADS, HEAD_DIM), 0.1),
        'rwkv_ln_g': gain((n_rwkv, PRIMARY_WIDTH)),
        'rwkv_ln_b': nrm((n_rwkv, PRIMARY_WIDTH), 0.02),
    }


def reference(x, mem, positions, mem_norm_g, w_mem_kv, pre_mix_g, post_mix_g, pre_ffn_g, post_ffn_g,
              w_out, w_ffn_in, w_ffn_out, nsa_w_in, nsa_gate_b, nsa_cmp_pos_k, nsa_cmp_pos_v,
              nsa_cmp_k_w1, nsa_cmp_k_w2, nsa_cmp_v_w1, nsa_cmp_v_w2, rwkv_w_in, rwkv_mu, rwkv_w0,
              rwkv_w2, rwkv_a0, rwkv_a2, rwkv_g2, rwkv_k_k, rwkv_k_a, rwkv_r_k, rwkv_ln_g, rwkv_ln_b):
    B, S, _ = x.shape
    M = mem.shape[1]
    mkv = rmsnorm(mem, mem_norm_g) @ w_mem_kv
    mem_k = mkv[..., :MEM_WIDTH].reshape(B, M, MEM_HEADS, HEAD_DIM)
    mem_v = mkv[..., MEM_WIDTH:].reshape(B, M, MEM_HEADS, HEAD_DIM)
    cos, sin = rope_tables(positions)
    h = x
    for i in range(DEPTH):
        j = i // 2
        hn = rmsnorm(h, pre_mix_g[i])
        if i % 2 == 0:
            proj = hn @ nsa_w_in[j]
            prim = nsa_mixer(proj[..., :NSA_IN - MEM_WIDTH], cos, sin, nsa_gate_b[j], nsa_cmp_pos_k[j],
                             nsa_cmp_pos_v[j], nsa_cmp_k_w1[j], nsa_cmp_k_w2[j], nsa_cmp_v_w1[j], nsa_cmp_v_w2[j])
        else:
            proj = hn @ rwkv_w_in[j]
            prim = rwkv7_time_mix(proj[..., :RWKV_SHIFT_W], rwkv_mu[j], rwkv_w0[j], rwkv_w2[j], rwkv_a0[j],
                                  rwkv_a2[j], rwkv_g2[j], rwkv_k_k[j], rwkv_k_a[j], rwkv_r_k[j],
                                  rwkv_ln_g[j], rwkv_ln_b[j])
        mo = memory_attention(proj[..., -MEM_WIDTH:], mem_k, mem_v)
        mix = jnp.concatenate([prim, mo], axis=-1) @ w_out[i]
        h = h + rmsnorm(mix, post_mix_g[i])
        hn = rmsnorm(h, pre_ffn_g[i])
        gu = hn @ w_ffn_in[i]
        ff = (jax.nn.silu(gu[..., :FFN_HIDDEN]) * gu[..., FFN_HIDDEN:]) @ w_ffn_out[i]
        h = h + rmsnorm(ff, post_ffn_g[i])
    return h
```

```cpp
#include <hip/hip_runtime.h>
#include <hip/hip_cooperative_groups.h>
#include <cstdio>
#include <cstdint>
namespace cg = cooperative_groups;

#define LAS __attribute__((address_space(3)))
typedef unsigned short bf16_t;
typedef short bf16x8 __attribute__((ext_vector_type(8)));
typedef float f32x4 __attribute__((ext_vector_type(4)));
typedef float f32x2 __attribute__((ext_vector_type(2)));
typedef unsigned u32x4 __attribute__((ext_vector_type(4)));
typedef unsigned u32x2 __attribute__((ext_vector_type(2)));

constexpr int BATCH = 2, SEQ = 8192, MTOK = BATCH * SEQ, DM = 1024;
constexpr int NMEM = 256, HD = 64;
constexpr int NSA_N = 2212, NSA_NP = 2304;
constexpr int RWKV_N = 2816, FFN_H = 2816, FFN_N2 = 5632;
constexpr int PRIM = 768;
constexpr float NORM_EPS = 1e-6f;
constexpr int NTHREADS = 512, NWAVES = 8;
constexpr int LDS_BYTES = 147456;

constexpr size_t MiB = 1u << 20;
constexpr size_t WS_WT_NSA = 1 * MiB, WS_WT_RWKV = 6 * MiB, WS_WT_OUT = 12 * MiB, WS_WT_FIN = 16 * MiB, WS_WT_FOUT = 38 * MiB;
constexpr size_t WS_WT_C1K = 49 * MiB, WS_WT_C1V = 50 * MiB, WS_WT_MKV = 51 * MiB;
constexpr size_t WS_MEMN = 52 * MiB, WS_MKV = 53 * MiB, WS_COS = 53 * MiB + 512 * 1024, WS_SIN = 54 * MiB;
constexpr size_t WS_KC = 54 * MiB + 512 * 1024, WS_VC = 55 * MiB, WS_BIASK = 55 * MiB + 512 * 1024, WS_BIASV = WS_BIASK + 4096;
constexpr size_t WS_GATES = 56 * MiB, WS_CMPHK = 59 * MiB, WS_CMPHV = 60 * MiB + 512 * 1024;
constexpr size_t WS_HN_A = 64 * MiB, WS_OA = 96 * MiB, WS_FF = 64 * MiB;
constexpr size_t WS_Q = 128 * MiB, WS_KV6 = 152 * MiB, WS_QM = 188 * MiB;
constexpr size_t WS_MIX0 = 192 * MiB, WS_MIX1 = 128 * MiB, WS_ACT = 128 * MiB, WS_HN_B = 216 * MiB, WS_PROJ1 = 128 * MiB;
constexpr size_t KV6_STRIDE = (size_t)BATCH * 3 * SEQ * HD;

__device__ __forceinline__ unsigned f2bf(float f) { unsigned u = __builtin_bit_cast(unsigned, f); return (u + 0x7fffu + ((u >> 16) & 1u)) >> 16; }
__device__ __forceinline__ unsigned pk2(float lo, float hi) { return f2bf(lo) | (f2bf(hi) << 16); }
__device__ __forceinline__ float bf_lo(unsigned u) { return __builtin_bit_cast(float, u << 16); }
__device__ __forceinline__ float bf_hi(unsigned u) { return __builtin_bit_cast(float, u & 0xffff0000u); }
__device__ __forceinline__ float bf2f(bf16_t h) { return __builtin_bit_cast(float, (unsigned)h << 16); }
__device__ __forceinline__ float wave_sum(float v) {
#pragma unroll
    for (int o = 1; o < 64; o <<= 1) v += __shfl_xor(v, o);
    return v;
}
__device__ __forceinline__ float wave_max(float v) {
#pragma unroll
    for (int o = 1; o < 64; o <<= 1) v = fmaxf(v, __shfl_xor(v, o));
    return v;
}
__device__ __forceinline__ float sigmoidf_(float x) { return 1.0f / (1.0f + __expf(-x)); }
__device__ __forceinline__ float gelu_tanh(float x) { return 0.5f * x * (1.0f + tanhf(0.7978845608028654f * (x + 0.044715f * x * x * x))); }
#define LDS_FENCE() asm volatile("s_waitcnt lgkmcnt(0)" ::: "memory")

namespace pg8 {
constexpr int BM = 256, BK = 64, HALF = 128, HTB = HALF * BK * 2, STAGE_BYTES = 8 * HTB, NXCD = 8, WGM = 8;
__host__ __device__ __forceinline__ int lds_byte(int r, int c) { const int st = (r >> 4) * 2 + (c >> 5), rr = r & 15, cc = c & 31, ob = rr * 64 + cc * 2; return st * 1024 + (ob ^ (((ob >> 9) & 1) << 5)); }
__host__ __device__ __forceinline__ void stage_rc(int b, int& R, int& C) { const int st = b / 1024, sb = b % 1024, swz = sb ^ (((sb >> 9) & 1) << 5); R = (st >> 1) * 16 + swz / 64; C = (st & 1) * 32 + (swz % 64) / 2; }
__host__ __device__ __forceinline__ int perm32(int rho) { const int n = rho >> 4, i = rho & 15; return 8 * (i >> 2) + 4 * n + (i & 3); }

struct Unit { int pm, pn; };
struct Gemm { const bf16_t* A; const bf16_t* Bt; int M, N, K, lda; };

struct StaticOrder {
    int nM, nN, nwg, G, c;
    __device__ void init(int M, int N, int G_, int c_) { nM = M / BM; nN = N / BM; nwg = nM * nN; G = G_; c = c_; }
    __device__ bool next(int i, Unit& u) const {
        const long L = (long)i * G + c; if (L >= nwg) return false;
        int wgid = (int)L; { const int q = nwg / NXCD, r = nwg % NXCD, xcd = wgid % NXCD, off = wgid / NXCD; wgid = (xcd < r ? xcd * (q + 1) : r * (q + 1) + (xcd - r) * q) + off; }
        const int nig = WGM * nN, gid = wgid / nig, fm = gid * WGM, gsz = (nM - fm) < WGM ? (nM - fm) : WGM;
        u.pm = fm + ((wgid % nig) % gsz); u.pn = (wgid % nig) / gsz; return true;
    }
};

template <class Epi, bool ALIGN_EPI>
__device__ __forceinline__ void gemm_phase(LAS unsigned char* lds, const Gemm g, const StaticOrder& S, const Epi& E) {
    const int tid = threadIdx.x, wid = __builtin_amdgcn_readfirstlane(tid >> 6), lane = tid & 63, wr = wid >> 2, wc = wid & 3, fr = lane & 15, fq = lane >> 4;
    const int K = g.K, nt = K / BK, lda = g.lda;
    unsigned voffA[2], voffB[2];
#pragma unroll
    for (int i = 0; i < 2; ++i) { int R, C; stage_rc(tid * 16 + i * 8192, R, C); const int Rb = Epi::PERM ? ((R & ~31) + perm32(R & 31)) : R;
        voffA[i] = (unsigned)(R * lda + C) * 2u; voffB[i] = (unsigned)(Rb * K + C) * 2u; }
    const size_t kstep = (size_t)(BK * 2);
    const size_t hstepA = (size_t)HALF * lda * 2, hstepB = (size_t)HALF * K * 2;
    const size_t tstepA = 2 * hstepA, tstepB = 2 * hstepB;
    const unsigned ldsw = (unsigned)wid * 1024u;
    const int aoff = lds_byte(wr * 64 + fr, fq * 8), boff = lds_byte(wc * 32 + fr, fq * 8);
#define PG8_SA(b, h) (((b) * 2 + (h)) * HTB)
#define PG8_SB(b, h) ((4 + (b) * 2 + (h)) * HTB)
#define PG8_STAGE(bufoff, gbase, voff) do { _Pragma("unroll") for (int _i = 0; _i < 2; ++_i) \
        __builtin_amdgcn_global_load_lds((const unsigned*)((const char*)(gbase) + (voff)[_i]), (LAS unsigned*)(lds + (bufoff) + ldsw + _i * 8192), 16, 0, 0); } while (0)
#define PG8_LDA(dst, b, h) do { _Pragma("unroll") for (int m = 0; m < 4; ++m) _Pragma("unroll") for (int k = 0; k < 2; ++k) dst[m][k] = *(const LAS bf16x8*)(lds + PG8_SA(b, h) + aoff + m * 2048 + k * 1024); } while (0)
#define PG8_LDB(dst, b, h) do { _Pragma("unroll") for (int n = 0; n < 2; ++n) _Pragma("unroll") for (int k = 0; k < 2; ++k) dst[n][k] = *(const LAS bf16x8*)(lds + PG8_SB(b, h) + boff + n * 2048 + k * 1024); } while (0)
#define PG8_MMA(ai, bj, At, Bt) do { __builtin_amdgcn_s_setprio(1); _Pragma("unroll") for (int m = 0; m < 4; ++m) _Pragma("unroll") for (int n = 0; n < 2; ++n) _Pragma("unroll") for (int k = 0; k < 2; ++k) \
        acc[ai][bj][m][n] = __builtin_amdgcn_mfma_f32_16x16x32_bf16(Bt[n][k], At[m][k], acc[ai][bj][m][n], 0, 0, 0); __builtin_amdgcn_s_setprio(0); } while (0)
#define PG8_WAIT_V(n) asm volatile("s_waitcnt vmcnt(" #n ")" ::: "memory")
#define PG8_WAIT_L(n) asm volatile("s_waitcnt lgkmcnt(" #n ")" ::: "memory")
#define PG8_BAR __builtin_amdgcn_s_barrier()
#define PG8_SCHED __builtin_amdgcn_sched_barrier(0)
    Unit cur, nxt; int ui = 0;
    if (!S.next(0, cur)) return;
    f32x4 acc[2][2][4][2];
#pragma unroll
    for (int a = 0; a < 2; ++a)
#pragma unroll
        for (int b = 0; b < 2; ++b)
#pragma unroll
            for (int m = 0; m < 4; ++m)
#pragma unroll
                for (int n = 0; n < 2; ++n) acc[a][b][m][n] = (f32x4){0.f, 0.f, 0.f, 0.f};
    bf16x8 At[4][2], B0[2][2], B1[2][2];
    const char* cA = (const char*)g.A + (size_t)cur.pm * tstepA; const char* cB = (const char*)g.Bt + (size_t)cur.pn * tstepB;
    PG8_STAGE(PG8_SB(0, 0), cB, voffB); PG8_STAGE(PG8_SB(0, 1), cB + hstepB, voffB); PG8_STAGE(PG8_SA(0, 0), cA, voffA); PG8_STAGE(PG8_SA(0, 1), cA + hstepA, voffA);
    if (wr == 1) PG8_BAR;
    PG8_WAIT_V(2); PG8_BAR;
    PG8_STAGE(PG8_SB(1, 0), cB + kstep, voffB); PG8_STAGE(PG8_SA(1, 0), cA + kstep, voffA); PG8_STAGE(PG8_SB(1, 1), cB + hstepB + kstep, voffB);
    PG8_WAIT_V(6); PG8_BAR;
    for (;;) {
        const bool has_next = S.next(ui + 1, nxt);
        const char* nA = has_next ? (const char*)g.A + (size_t)nxt.pm * tstepA : cA; const char* nB = has_next ? (const char*)g.Bt + (size_t)nxt.pn * tstepB : cB;
        for (int t = 0; t < nt; t += 2) {
            const bool last = (t == nt - 2);
            const char* a1 = cA + (size_t)(t + 1) * kstep;
            const char* a2 = last ? nA : cA + (size_t)(t + 2) * kstep; const char* b2 = last ? nB : cB + (size_t)(t + 2) * kstep;
            const char* a3 = a2 + kstep; const char* b3 = b2 + kstep;
            PG8_LDB(B0, 0, 0); PG8_LDB(B1, 0, 1); PG8_SCHED; PG8_LDA(At, 0, 0); PG8_STAGE(PG8_SA(1, 1), a1 + hstepA, voffA);
            PG8_WAIT_V(8); PG8_WAIT_L(0); PG8_BAR; PG8_MMA(0, 0, At, B0); PG8_MMA(0, 1, At, B1); PG8_BAR; PG8_SCHED;
            PG8_LDA(At, 0, 1); PG8_STAGE(PG8_SB(0, 0), b2, voffB); PG8_STAGE(PG8_SB(0, 1), b2 + hstepB, voffB); PG8_STAGE(PG8_SA(0, 0), a2, voffA);
            PG8_WAIT_V(8); PG8_WAIT_L(0); PG8_BAR; PG8_MMA(1, 0, At, B0); PG8_MMA(1, 1, At, B1); PG8_BAR; PG8_SCHED;
            PG8_LDB(B0, 1, 0); PG8_LDB(B1, 1, 1); PG8_SCHED; PG8_LDA(At, 1, 0); PG8_STAGE(PG8_SA(0, 1), a2 + hstepA, voffA);
            PG8_WAIT_V(8); PG8_WAIT_L(0); PG8_BAR; PG8_MMA(0, 0, At, B0); PG8_MMA(0, 1, At, B1); PG8_BAR; PG8_SCHED;
            PG8_LDA(At, 1, 1); PG8_STAGE(PG8_SB(1, 0), b3, voffB); PG8_STAGE(PG8_SB(1, 1), b3 + hstepB, voffB); PG8_STAGE(PG8_SA(1, 0), a3, voffA);
            PG8_WAIT_V(8); PG8_WAIT_L(0); PG8_BAR; PG8_MMA(1, 0, At, B0); PG8_MMA(1, 1, At, B1); PG8_BAR; PG8_SCHED;
        }
        if constexpr (ALIGN_EPI) { if (wr == 0) PG8_BAR; }
        E(acc, cur, wr, wc, fr, fq);
        if (!has_next) break;
#pragma unroll
        for (int a = 0; a < 2; ++a)
#pragma unroll
            for (int b = 0; b < 2; ++b)
#pragma unroll
                for (int m = 0; m < 4; ++m)
#pragma unroll
                    for (int n = 0; n < 2; ++n) acc[a][b][m][n] = (f32x4){0.f, 0.f, 0.f, 0.f};
        cur = nxt; cA = nA; cB = nB; ++ui;
        if constexpr (ALIGN_EPI) { if (wr == 1) PG8_BAR; }
    }
    PG8_WAIT_V(0);
    if constexpr (!ALIGN_EPI) { if (wr == 0) PG8_BAR; }
    PG8_BAR;
#undef PG8_SA
#undef PG8_SB
#undef PG8_STAGE
#undef PG8_LDA
#undef PG8_LDB
#undef PG8_MMA
#undef PG8_WAIT_V
#undef PG8_WAIT_L
#undef PG8_BAR
#undef PG8_SCHED
}

struct EpiBf16 {
    static constexpr bool PERM = true;
    bf16_t* O; int ldc;
    __device__ __forceinline__ void operator()(const f32x4 (&acc)[2][2][4][2], const Unit& u, int wr, int wc, int fr, int fq) const {
        const int row0 = u.pm * BM + wr * 64 + fr, col0 = u.pn * BM + wc * 32 + 8 * fq;
#pragma unroll
        for (int ai = 0; ai < 2; ++ai)
#pragma unroll
            for (int m = 0; m < 4; ++m) { bf16_t* rowp = O + (size_t)(row0 + ai * HALF + m * 16) * ldc + col0;
#pragma unroll
                for (int bj = 0; bj < 2; ++bj) { const f32x4 v0 = acc[ai][bj][m][0], v1 = acc[ai][bj][m][1];
                    u32x4 w; w.x = pk2(v0[0], v0[1]); w.y = pk2(v0[2], v0[3]); w.z = pk2(v1[0], v1[1]); w.w = pk2(v1[2], v1[3]);
                    *(u32x4*)(rowp + bj * HALF) = w; } }
    }
};
struct EpiGeluBias {
    static constexpr bool PERM = true;
    bf16_t* O; int ldc; const float* bias;
    __device__ __forceinline__ void operator()(const f32x4 (&acc)[2][2][4][2], const Unit& u, int wr, int wc, int fr, int fq) const {
        const int row0 = u.pm * BM + wr * 64 + fr, col0 = u.pn * BM + wc * 32 + 8 * fq;
#pragma unroll
        for (int bj = 0; bj < 2; ++bj) {
            const f32x4 b0 = *(const f32x4*)(bias + col0 + bj * HALF), b1 = *(const f32x4*)(bias + col0 + bj * HALF + 4);
#pragma unroll
            for (int ai = 0; ai < 2; ++ai)
#pragma unroll
                for (int m = 0; m < 4; ++m) { bf16_t* rowp = O + (size_t)(row0 + ai * HALF + m * 16) * ldc + col0 + bj * HALF;
                    const f32x4 v0 = acc[ai][bj][m][0] + b0, v1 = acc[ai][bj][m][1] + b1;
                    u32x4 w; w.x = pk2(gelu_tanh(v0[0]), gelu_tanh(v0[1])); w.y = pk2(gelu_tanh(v0[2]), gelu_tanh(v0[3]));
                    w.z = pk2(gelu_tanh(v1[0]), gelu_tanh(v1[1])); w.w = pk2(gelu_tanh(v1[2]), gelu_tanh(v1[3]));
                    *(u32x4*)rowp = w; } }
    }
};
struct EpiSwiglu {
    static constexpr bool PERM = true;
    bf16_t* O; int ldc;
    __device__ __forceinline__ void operator()(const f32x4 (&acc)[2][2][4][2], const Unit& u, int wr, int wc, int fr, int fq) const {
        const int row0 = u.pm * BM + wr * 64 + fr, col0 = u.pn * HALF + wc * 32 + 8 * fq;
#pragma unroll
        for (int ai = 0; ai < 2; ++ai)
#pragma unroll
            for (int m = 0; m < 4; ++m) { bf16_t* rowp = O + (size_t)(row0 + ai * HALF + m * 16) * ldc + col0;
                float r[8];
#pragma unroll
                for (int n = 0; n < 2; ++n)
#pragma unroll
                    for (int i = 0; i < 4; ++i) { const float gg = acc[ai][0][m][n][i], uu = acc[ai][1][m][n][i]; r[n * 4 + i] = gg / (1.0f + __expf(-gg)) * uu; }
                u32x4 w; w.x = pk2(r[0], r[1]); w.y = pk2(r[2], r[3]); w.z = pk2(r[4], r[5]); w.w = pk2(r[6], r[7]);
                *(u32x4*)rowp = w; }
    }
};
struct EpiF32 {
    static constexpr bool PERM = false;
    float* O; int ldc;
    __device__ __forceinline__ void operator()(const f32x4 (&acc)[2][2][4][2], const Unit& u, int wr, int wc, int fr, int fq) const {
        const int col0 = u.pn * BM + wc * 32 + 4 * fq;
#pragma unroll
        for (int ai = 0; ai < 2; ++ai)
#pragma unroll
            for (int m = 0; m < 4; ++m) { const int r = ai * HALF + wr * 64 + m * 16 + fr; float* rowp = O + (size_t)(u.pm * BM + r) * ldc + col0;
#pragma unroll
                for (int bj = 0; bj < 2; ++bj)
#pragma unroll
                    for (int n = 0; n < 2; ++n) *(f32x4*)(rowp + bj * HALF + n * 16) = acc[ai][bj][m][n]; }
    }
};
struct EpiNsaSplit {
    static constexpr bool PERM = true;
    bf16_t* Q; bf16_t* KV6; bf16_t* QM; float* GATES; const float* gate_b;
    __device__ __forceinline__ void operator()(const f32x4 (&acc)[2][2][4][2], const Unit& u, int wr, int wc, int fr, int fq) const {
        const int row0 = u.pm * BM + wr * 64 + fr;
#pragma unroll
        for (int bj = 0; bj < 2; ++bj) {
            const int c = u.pn * BM + bj * HALF + wc * 32 + 8 * fq;
#pragma unroll
            for (int ai = 0; ai < 2; ++ai)
#pragma unroll
                for (int m = 0; m < 4; ++m) {
                    const int row = row0 + ai * HALF + m * 16;
                    const f32x4 v0 = acc[ai][bj][m][0], v1 = acc[ai][bj][m][1];
                    if (c < 2176) {
                        bf16_t* dst;
                        if (c < 768) dst = Q + (size_t)row * 768 + c;
                        else if (c < 1920) { const int cc = c - 768, idx = cc / 192, rem = cc % 192, gg = rem >> 6, d = rem & 63, b = row >> 13, s = row & 8191;
                            dst = KV6 + (size_t)idx * KV6_STRIDE + ((size_t)(b * 3 + gg) * SEQ + s) * HD + d; }
                        else dst = QM + (size_t)row * 256 + (c - 1920);
                        u32x4 w; w.x = pk2(v0[0], v0[1]); w.y = pk2(v0[2], v0[3]); w.z = pk2(v1[0], v1[1]); w.w = pk2(v1[2], v1[3]);
                        *(u32x4*)dst = w;
                    } else if (c < 2212) {
#pragma unroll
                        for (int e = 0; e < 8; ++e) { const int cgi = c - 2176 + e; const float v = e < 4 ? v0[e & 3] : v1[e & 3];
                            if (cgi < 36) GATES[(size_t)row * 36 + cgi] = sigmoidf_(v + gate_b[cgi]); }
                    }
                }
        }
    }
};
}

struct Args { const float* in[32]; float* out; unsigned char* ws; };

template <class RowMap>
__device__ __forceinline__ void transpose_item(const float* W, int K, int N, bf16_t* WT, const RowMap& rm, LAS float* scr, int item, int lane) {
    const int nblk = (N + 31) / 32, kb = item / nblk, nb = item % nblk, k0 = 64 * kb, n0 = 32 * nb;
    const int nn = n0 + (lane & 31);
#pragma unroll 8
    for (int i = 0; i < 32; ++i) { const int kk = 2 * i + (lane >> 5); scr[kk * 33 + (lane & 31)] = (nn < N) ? W[(size_t)(k0 + kk) * N + nn] : 0.f; }
    LDS_FENCE();
    const int c = lane & 7;
#pragma unroll
    for (int j = 0; j < 4; ++j) { const int n = (lane >> 3) + 8 * j; const LAS float* s = scr + (8 * c) * 33 + n;
        u32x4 o; o.x = pk2(s[0 * 33], s[1 * 33]); o.y = pk2(s[2 * 33], s[3 * 33]); o.z = pk2(s[4 * 33], s[5 * 33]); o.w = pk2(s[6 * 33], s[7 * 33]);
        if (n0 + n < N) *(u32x4*)(WT + (size_t)rm(n0 + n) * K + k0 + 8 * c) = o; }
    LDS_FENCE();
}
struct MapId { __device__ __forceinline__ int operator()(int n) const { return n; } };
struct MapNsa { __device__ __forceinline__ int operator()(int n) const { return n < 1920 ? n : (n < 1956 ? n - 1920 + 2176 : n - 1956 + 1920); } };
struct MapFfn { __device__ __forceinline__ int operator()(int n) const { const int j = n < FFN_H ? n : n - FFN_H; return (j >> 7) * 256 + (n < FFN_H ? 0 : 128) + (j & 127); } };

__device__ __forceinline__ void rms_row_to_bf16(const float* xrow, const float* g, bf16_t* orow, int lane) {
    const f32x4* xr = (const f32x4*)xrow + lane; const f32x4* gr = (const f32x4*)g + lane;
    f32x4 v[4]; float s = 0.f;
#pragma unroll
    for (int j = 0; j < 4; ++j) { v[j] = xr[64 * j]; s += (v[j].x * v[j].x + v[j].y * v[j].y) + (v[j].z * v[j].z + v[j].w * v[j].w); }
    const float r = rsqrtf(wave_sum(s) * (1.f / DM) + NORM_EPS);
    u32x2* o8 = (u32x2*)orow + lane;
#pragma unroll
    for (int j = 0; j < 4; ++j) { const f32x4 gg = gr[64 * j]; u32x2 w; w.x = pk2(v[j].x * r * gg.x, v[j].y * r * gg.y); w.y = pk2(v[j].z * r * gg.z, v[j].w * r * gg.w); o8[64 * j] = w; }
}
__device__ __forceinline__ void res_row(const float* base, const float* y, const float* gpost, const float* gnext, float* out, bf16_t* hn, int lane) {
    const f32x4* yr = (const f32x4*)y + lane; const f32x4* br = (const f32x4*)base + lane; const f32x4* gp = (const f32x4*)gpost + lane;
    f32x4 v[4]; float s = 0.f;
#pragma unroll
    for (int j = 0; j < 4; ++j) { v[j] = yr[64 * j]; s += (v[j].x * v[j].x + v[j].y * v[j].y) + (v[j].z * v[j].z + v[j].w * v[j].w); }
    const float r = rsqrtf(wave_sum(s) * (1.f / DM) + NORM_EPS);
    float s2 = 0.f;
#pragma unroll
    for (int j = 0; j < 4; ++j) { const f32x4 gg = gp[64 * j], bb = br[64 * j]; v[j] = bb + v[j] * r * gg; s2 += (v[j].x * v[j].x + v[j].y * v[j].y) + (v[j].z * v[j].z + v[j].w * v[j].w); }
    f32x4* orow = (f32x4*)out + lane;
#pragma unroll
    for (int j = 0; j < 4; ++j) orow[64 * j] = v[j];
    if (hn) {
        const float r2 = rsqrtf(wave_sum(s2) * (1.f / DM) + NORM_EPS);
        const f32x4* gn = (const f32x4*)gnext + lane; u32x2* o8 = (u32x2*)hn + lane;
#pragma unroll
        for (int j = 0; j < 4; ++j) { const f32x4 gg = gn[64 * j]; u32x2 w; w.x = pk2(v[j].x * r2 * gg.x, v[j].y * r2 * gg.y); w.y = pk2(v[j].z * r2 * gg.z, v[j].w * r2 * gg.w); o8[64 * j] = w; }
    }
}

__device__ __forceinline__ f32x4 dot4(const bf16_t* krow, const LAS float* qs) {
    const u32x4* kp = (const u32x4*)krow; f32x4 s = (f32x4){0.f, 0.f, 0.f, 0.f};
#pragma unroll
    for (int c = 0; c < 8; ++c) { const u32x4 kv = kp[c];
#pragma unroll
        for (int e = 0; e < 4; ++e) { const unsigned w = kv[e]; const f32x4 q0 = *(const LAS f32x4*)(qs + (c * 8 + e * 2) * 4), q1 = *(const LAS f32x4*)(qs + (c * 8 + e * 2 + 1) * 4);
            s += q0 * bf_lo(w); s += q1 * bf_hi(w); } }
    return s;
}
__device__ __forceinline__ void softmax4(LAS f32x4* sc, int n, int lane) {
    f32x4 mx = (f32x4){-INFINITY, -INFINITY, -INFINITY, -INFINITY};
    for (int i = lane; i < n; i += 64) { const f32x4 v = sc[i]; mx.x = fmaxf(mx.x, v.x); mx.y = fmaxf(mx.y, v.y); mx.z = fmaxf(mx.z, v.z); mx.w = fmaxf(mx.w, v.w); }
    mx.x = wave_max(mx.x); mx.y = wave_max(mx.y); mx.z = wave_max(mx.z); mx.w = wave_max(mx.w);
    f32x4 sm = (f32x4){0.f, 0.f, 0.f, 0.f};
    for (int i = lane; i < n; i += 64) { f32x4 v = sc[i]; v.x = __expf(v.x - mx.x); v.y = __expf(v.y - mx.y); v.z = __expf(v.z - mx.z); v.w = __expf(v.w - mx.w); sc[i] = v; sm += v; }
    sm.x = wave_sum(sm.x); sm.y = wave_sum(sm.y); sm.z = wave_sum(sm.z); sm.w = wave_sum(sm.w);
    const f32x4 inv = (f32x4){1.f / fmaxf(sm.x, 1e-30f), 1.f / fmaxf(sm.y, 1e-30f), 1.f / fmaxf(sm.z, 1e-30f), 1.f / fmaxf(sm.w, 1e-30f)};
    for (int i = lane; i < n; i += 64) sc[i] = sc[i] * inv;
    LDS_FENCE();
}

struct NsaPtrs { const bf16_t* Q; const bf16_t* KV6; const bf16_t* KC; const bf16_t* VC; const float* GATES; bf16_t* OA; };

__device__ __forceinline__ void nsa_item(const NsaPtrs& P, int item, LAS unsigned char* wl, int lane) {
    LAS f32x4* sc = (LAS f32x4*)wl;
    LAS float* qs = (LAS float*)(wl + 16384);
    LAS float* impl = (LAS float*)(wl + 16384 + 1024);
    LAS int* sel = (LAS int*)(wl + 16384 + 1024 + 512);
    const int g = item % 3, row = item / 3, b = row >> 13, t = row & 8191;
    const size_t bg = (size_t)(b * 3 + g);
#pragma unroll
    for (int h = 0; h < 4; ++h) qs[lane * 4 + h] = bf2f(P.Q[(size_t)row * 768 + (g * 4 + h) * 64 + lane]) * 0.125f;
    LDS_FENCE();
    float oc[4] = {0.f, 0.f, 0.f, 0.f}, os[4] = {0.f, 0.f, 0.f, 0.f}, ow[4] = {0.f, 0.f, 0.f, 0.f};
    const int cur = t >> 6;
    const int nv = (t >= 31) ? (((t - 31) >> 4) + 1 > 511 ? 511 : ((t - 31) >> 4) + 1) : 0;
    const bf16_t* KCb = P.KC + bg * 512 * 64; const bf16_t* VCb = P.VC + bg * 512 * 64;
    for (int n0 = 0; n0 < nv; n0 += 64) { const int n = n0 + lane; if (n < nv) sc[n] = dot4(KCb + (size_t)n * 64, qs); }
    LDS_FENCE();
    softmax4(sc, nv, lane);
    for (int n = 0; n < nv; ++n) { const f32x4 p = sc[n]; const float v = bf2f(VCb[(size_t)n * 64 + lane]); oc[0] += p.x * v; oc[1] += p.y * v; oc[2] += p.z * v; oc[3] += p.w * v; }
    float imp0 = 0.f, imp1 = 0.f;
#pragma unroll
    for (int o = 0; o < 5; ++o) { const float tw = (o == 0 || o == 4) ? 1.f : 2.f;
        { const int n = 4 * lane + o - 1; if (n >= 0 && n < nv) { const f32x4 p = sc[n]; imp0 += tw * ((p.x + p.y) + (p.z + p.w)); } }
        { const int n = 4 * (lane + 64) + o - 1; if (n < nv) { const f32x4 p = sc[n]; imp1 += tw * ((p.x + p.y) + (p.z + p.w)); } } }
    impl[lane] = imp0; impl[lane + 64] = imp1;
    LDS_FENCE();
    int nsel;
    if (cur < 16) { nsel = cur + 1; if (lane < 16) sel[lane] = lane; }
    else {
        const int lo = 1, hi = cur - 2;
        int r0 = 0, r1 = 0; const int j0 = lane, j1 = lane + 64;
        for (int j = lo; j <= hi; ++j) { const float v = impl[j]; r0 += (v > imp0 || (v == imp0 && j < j0)) ? 1 : 0; r1 += (v > imp1 || (v == imp1 && j < j1)) ? 1 : 0; }
        const bool s0 = (j0 >= lo && j0 <= hi && r0 < 13), s1 = (j1 >= lo && j1 <= hi && r1 < 13);
        const unsigned long long m0 = __ballot(s0), m1 = __ballot(s1);
        const unsigned long long below = (lane == 0) ? 0ull : (~0ull >> (64 - lane));
        const int c0 = __popcll(m0);
        if (s0) sel[3 + __popcll(m0 & below)] = j0;
        if (s1) sel[3 + c0 + __popcll(m1 & below)] = j1;
        if (lane == 0) { sel[0] = 0; sel[1] = cur - 1; sel[2] = cur; }
        nsel = 3 + c0 + __popcll(m1);
        if (nsel > 16) nsel = 16;
    }
    LDS_FENCE();
    {
        const bf16_t* Kb = P.KV6 + 2 * KV6_STRIDE + bg * SEQ * 64; const bf16_t* Vb = P.KV6 + 3 * KV6_STRIDE + bg * SEQ * 64;
        for (int i = 0; i < nsel; ++i) { const int key = sel[i] * 64 + lane;
            sc[i * 64 + lane] = (key <= t) ? dot4(Kb + (size_t)key * 64, qs) : (f32x4){-INFINITY, -INFINITY, -INFINITY, -INFINITY}; }
        LDS_FENCE();
        softmax4(sc, nsel * 64, lane);
        for (int i = 0; i < nsel; ++i) { const int kb = sel[i] * 64; const int kmax = (t - kb + 1) < 64 ? (t - kb + 1) : 64;
            for (int kk = 0; kk < kmax; ++kk) { const f32x4 p = sc[i * 64 + kk]; const float v = bf2f(Vb[(size_t)(kb + kk) * 64 + lane]); os[0] += p.x * v; os[1] += p.y * v; os[2] += p.z * v; os[3] += p.w * v; } }
    }
    LDS_FENCE();
    {
        const bf16_t* Kb = P.KV6 + 4 * KV6_STRIDE + bg * SEQ * 64; const bf16_t* Vb = P.KV6 + 5 * KV6_STRIDE + bg * SEQ * 64;
        const int k0 = (t - 511) > 0 ? (t - 511) : 0, nk = t - k0 + 1;
        for (int n0 = 0; n0 < nk; n0 += 64) { const int n = n0 + lane; if (n < nk) sc[n] = dot4(Kb + (size_t)(k0 + n) * 64, qs); }
        LDS_FENCE();
        softmax4(sc, nk, lane);
        for (int n = 0; n < nk; ++n) { const f32x4 p = sc[n]; const float v = bf2f(Vb[(size_t)(k0 + n) * 64 + lane]); ow[0] += p.x * v; ow[1] += p.y * v; ow[2] += p.z * v; ow[3] += p.w * v; }
    }
    LDS_FENCE();
#pragma unroll
    for (int h = 0; h < 4; ++h) { const float* gp = P.GATES + (size_t)row * 36 + (g * 4 + h) * 3;
        const float o = gp[0] * oc[h] + gp[1] * os[h] + gp[2] * ow[h];
        P.OA[(size_t)row * 1024 + (g * 4 + h) * 64 + lane] = (bf16_t)f2bf(o); }
}

__device__ __forceinline__ void mem_item(const bf16_t* qrow, const bf16_t* MKV, bf16_t* orow, int b, LAS unsigned char* wl, int lane) {
    LAS float* sc = (LAS float*)wl;
    LAS float* qs = (LAS float*)(wl + 16384);
#pragma unroll
    for (int h = 0; h < 4; ++h) qs[h * 64 + lane] = bf2f(qrow[h * 64 + lane]) * 0.125f;
    LDS_FENCE();
    const bf16_t* kvb = MKV + (size_t)b * 256 * 512;
    for (int h = 0; h < 4; ++h) {
        float sv[4]; float mx = -INFINITY;
#pragma unroll
        for (int i = 0; i < 4; ++i) { const int m = i * 64 + lane; const u32x4* kp = (const u32x4*)(kvb + (size_t)m * 512 + h * 64); float s = 0.f;
#pragma unroll
            for (int c = 0; c < 8; ++c) { const u32x4 kv = kp[c];
#pragma unroll
                for (int e = 0; e < 4; ++e) { s += bf_lo(kv[e]) * qs[h * 64 + c * 8 + e * 2]; s += bf_hi(kv[e]) * qs[h * 64 + c * 8 + e * 2 + 1]; } }
            sv[i] = s; mx = fmaxf(mx, s); }
        mx = wave_max(mx); float sm = 0.f;
#pragma unroll
        for (int i = 0; i < 4; ++i) { sv[i] = __expf(sv[i] - mx); sm += sv[i]; }
        sm = wave_sum(sm); const float inv = 1.f / sm;
#pragma unroll
        for (int i = 0; i < 4; ++i) sc[h * 256 + i * 64 + lane] = sv[i] * inv;
    }
    LDS_FENCE();
    for (int h = 0; h < 4; ++h) { float o = 0.f;
        for (int m = 0; m < 256; ++m) o += sc[h * 256 + m] * bf2f(kvb[(size_t)m * 512 + 256 + h * 64 + lane]);
        orow[h * 64 + lane] = (bf16_t)f2bf(o); }
    LDS_FENCE();
}

struct RwkvPtrs { const bf16_t* PROJ; const float *mu, *w0, *w2, *a0, *a2, *g2, *k_k, *k_a, *r_k, *ln_g, *ln_b; bf16_t* OA; };
constexpr int RCT = 16;
__device__ __forceinline__ void rwkv_unit(const RwkvPtrs& P, int b, int h, LAS unsigned char* lds, int tid) {
    const int lane = tid & 63, wave = tid >> 6;
    LAS float* W2s = (LAS float*)lds;
    LAS float* A2s = W2s + 4096;
    LAS float* G2s = A2s + 4096;
    LAS float* Rr = G2s + 8192;
    LAS float* Kr = Rr + RCT * 64; LAS float* Vr = Kr + RCT * 64; LAS float* WLs = Vr + RCT * 64; LAS float* ALs = WLs + RCT * 64;
    LAS float* GLs = ALs + RCT * 64;
    LAS float* DEC = GLs + RCT * 128; LAS float* Av = DEC + RCT * 64; LAS float* Bv = Av + RCT * 64; LAS float* Kp = Bv + RCT * 64; LAS float* Gt = Kp + RCT * 64; LAS float* Ys = Gt + RCT * 64;
    const int hc = h * 64;
    for (int i = tid; i < 4096; i += NTHREADS) { const int r = i >> 6, c = i & 63; W2s[i] = P.w2[(size_t)r * PRIM + hc + c]; A2s[i] = P.a2[(size_t)r * PRIM + hc + c]; }
    for (int i = tid; i < 8192; i += NTHREADS) { const int r = i >> 6, c = i & 63; G2s[i] = P.g2[(size_t)r * PRIM + hc + c]; }
    float St[16];
#pragma unroll
    for (int j = 0; j < 16; ++j) St[j] = 0.f;
    const int il = lane >> 2, jq = lane & 3, irow = wave * 16 + il;
    __syncthreads();
    for (int t0 = 0; t0 < SEQ; t0 += RCT) {
        for (int idx = tid; idx < RCT * 448; idx += NTHREADS) {
            const int tt = idx / 448, cc = idx % 448; const int t = t0 + tt;
            int col; LAS float* dst; int kind;
            if (cc < 64) { col = hc + cc; dst = Rr + tt * 64 + cc; kind = 0; }
            else if (cc < 128) { col = 768 + hc + cc - 64; dst = Kr + tt * 64 + cc - 64; kind = 0; }
            else if (cc < 192) { col = 1536 + hc + cc - 128; dst = Vr + tt * 64 + cc - 128; kind = 0; }
            else if (cc < 256) { col = 2304 + cc - 192; dst = WLs + tt * 64 + cc - 192; kind = 1; }
            else if (cc < 320) { col = 2368 + cc - 256; dst = ALs + tt * 64 + cc - 256; kind = 0; }
            else { col = 2432 + cc - 320; dst = GLs + tt * 128 + cc - 320; kind = 2; }
            const size_t rowi = (size_t)b * SEQ + t;
            const float p = bf2f(P.PROJ[rowi * RWKV_N + col]); const float pv = (t > 0) ? bf2f(P.PROJ[(rowi - 1) * RWKV_N + col]) : 0.f;
            float xs = p + (pv - p) * P.mu[col];
            if (kind == 1) xs = tanhf(xs); else if (kind == 2) xs = sigmoidf_(xs);
            *dst = xs;
        }
        __syncthreads();
        for (int rep = 0; rep < RCT / 8; ++rep) {
            const int tt = wave + 8 * rep, j = lane;
            float wd = P.w0[hc + j], av = P.a0[hc + j], gv = 0.f;
#pragma unroll 4
            for (int i = 0; i < 64; ++i) { wd += WLs[tt * 64 + i] * W2s[i * 64 + j]; av += ALs[tt * 64 + i] * A2s[i * 64 + j]; }
#pragma unroll 4
            for (int i = 0; i < 128; ++i) gv += GLs[tt * 128 + i] * G2s[i * 64 + j];
            const float nx = -wd; const float sp = (nx > 20.f) ? nx : log1pf(__expf(nx));
            const float w = -sp - 0.5f; const float dec = __expf(-__expf(w));
            const float a = sigmoidf_(av);
            const float kraw = Kr[tt * 64 + j];
            const float kkr = kraw * P.k_k[hc + j];
            const float ss = wave_sum(kkr * kkr);
            const float kk = kkr * rsqrtf(fmaxf(ss, 1e-24f));
            DEC[tt * 64 + j] = dec; Av[tt * 64 + j] = -kk; Bv[tt * 64 + j] = kk * a;
            Kp[tt * 64 + j] = kraw * (1.0f + (a - 1.0f) * P.k_a[hc + j]); Gt[tt * 64 + j] = gv;
        }
        __syncthreads();
        if (wave < 4) {
            for (int tt = 0; tt < RCT; ++tt) {
                const LAS f32x4* a4 = (const LAS f32x4*)(Av + tt * 64 + jq * 16); const LAS f32x4* w4 = (const LAS f32x4*)(DEC + tt * 64 + jq * 16);
                const LAS f32x4* b4 = (const LAS f32x4*)(Bv + tt * 64 + jq * 16); const LAS f32x4* k4 = (const LAS f32x4*)(Kp + tt * 64 + jq * 16);
                const LAS f32x4* r4 = (const LAS f32x4*)(Rr + tt * 64 + jq * 16);
                float sa = 0.f;
#pragma unroll
                for (int q = 0; q < 4; ++q) { const f32x4 av = a4[q];
#pragma unroll
                    for (int e = 0; e < 4; ++e) sa += St[q * 4 + e] * av[e]; }
                sa += __shfl_xor(sa, 1); sa += __shfl_xor(sa, 2);
                const float vi = Vr[tt * 64 + irow];
                float y = 0.f;
#pragma unroll
                for (int q = 0; q < 4; ++q) { const f32x4 wv = w4[q], bv = b4[q], kv = k4[q], rv = r4[q];
#pragma unroll
                    for (int e = 0; e < 4; ++e) { const float s = St[q * 4 + e] * wv[e] + sa * bv[e] + vi * kv[e]; St[q * 4 + e] = s; y += s * rv[e]; } }
                y += __shfl_xor(y, 1); y += __shfl_xor(y, 2);
                if (jq == 0) Ys[tt * 64 + irow] = y;
            }
        }
        __syncthreads();
        for (int rep = 0; rep < RCT / 8; ++rep) {
            const int tt = wave + 8 * rep, i = lane;
            const float y = Ys[tt * 64 + i];
            const float mean = wave_sum(y) * (1.f / 64.f); const float d = y - mean; const float var = wave_sum(d * d) * (1.f / 64.f);
            const float yn = d * rsqrtf(var + 64e-5f) * P.ln_g[hc + i] + P.ln_b[hc + i];
            const float bs = wave_sum(Rr[tt * 64 + i] * Kp[tt * 64 + i] * P.r_k[hc + i]);
            const float o = (yn + bs * Vr[tt * 64 + i]) * Gt[tt * 64 + i];
            P.OA[((size_t)b * SEQ + t0 + tt) * 1024 + hc + i] = (bf16_t)f2bf(o);
        }
        __syncthreads();
    }
}

__global__ void __launch_bounds__(NTHREADS, 2) fwd_kernel(Args a) {
    extern __shared__ __attribute__((aligned(16))) unsigned char lds_raw[];
    LAS unsigned char* lds = (LAS unsigned char*)lds_raw;
    cg::grid_group grid = cg::this_grid();
    const int tid = threadIdx.x, lane = tid & 63, wave = __builtin_amdgcn_readfirstlane(tid >> 6);
    const int G = gridDim.x, bid = blockIdx.x;
    const int gw = bid * NWAVES + wave, NGW = G * NWAVES;
    const int gtid = bid * NTHREADS + tid, NGT = G * NTHREADS;
#define IN(i) (a.in[i])
#define WSP(T, off) ((T*)(a.ws + (off)))
#define XIN IN(0)
#define MEMIN IN(1)
#define positions ((const int*)IN(2))
#define mem_norm_g IN(3)
#define w_mem_kv IN(4)
#define pre_mix_g IN(5)
#define post_mix_g IN(6)
#define pre_ffn_g IN(7)
#define post_ffn_g IN(8)
#define w_out IN(9)
#define w_ffn_in IN(10)
#define w_ffn_out IN(11)
#define nsa_w_in IN(12)
#define nsa_gate_b IN(13)
#define cmp_pos_k IN(14)
#define cmp_pos_v IN(15)
#define cmp_k_w1 IN(16)
#define cmp_k_w2 IN(17)
#define cmp_v_w1 IN(18)
#define cmp_v_w2 IN(19)
#define rwkv_w_in IN(20)
#define OUTP (a.out)
#define WT_NSA WSP(bf16_t, WS_WT_NSA)
#define WT_RWKV WSP(bf16_t, WS_WT_RWKV)
#define WT_OUT WSP(bf16_t, WS_WT_OUT)
#define WT_FIN WSP(bf16_t, WS_WT_FIN)
#define WT_FOUT WSP(bf16_t, WS_WT_FOUT)
#define WT_C1K WSP(bf16_t, WS_WT_C1K)
#define WT_C1V WSP(bf16_t, WS_WT_C1V)
#define WT_MKV WSP(bf16_t, WS_WT_MKV)
#define MEMN WSP(bf16_t, WS_MEMN)
#define MKV WSP(bf16_t, WS_MKV)
#define COS WSP(float, WS_COS)
#define SIN WSP(float, WS_SIN)
#define KC WSP(bf16_t, WS_KC)
#define VC WSP(bf16_t, WS_VC)
#define BIASK WSP(float, WS_BIASK)
#define BIASV WSP(float, WS_BIASV)
#define GATES WSP(float, WS_GATES)
#define CMPHK WSP(bf16_t, WS_CMPHK)
#define CMPHV WSP(bf16_t, WS_CMPHV)
#define HN_A WSP(bf16_t, WS_HN_A)
#define HN_B WSP(bf16_t, WS_HN_B)
#define OA WSP(bf16_t, WS_OA)
#define FF WSP(float, WS_FF)
#define Qb WSP(bf16_t, WS_Q)
#define KV6 WSP(bf16_t, WS_KV6)
#define QM WSP(bf16_t, WS_QM)
#define ACT WSP(bf16_t, WS_ACT)
#define PROJ1 WSP(bf16_t, WS_PROJ1)

    {
        LAS float* scr = (LAS float*)(lds + wave * 16384);
        const int I_NSA = (DM / 64) * ((NSA_N + 31) / 32), I_RWKV = (DM / 64) * (RWKV_N / 32), I_OUT = (DM / 64) * (DM / 32), I_FIN = (DM / 64) * (FFN_N2 / 32), I_FOUT = (FFN_H / 64) * (DM / 32);
        const int I_C1 = (2048 / 64) * (256 / 32), I_MKV = (DM / 64) * (512 / 32);
        const int NIT = I_NSA + I_RWKV + 2 * I_OUT + 2 * I_FIN + 2 * I_FOUT + 2 * I_C1 + I_MKV;
        for (int it = gw; it < NIT; it += NGW) {
            int r = it;
            if (r < I_NSA) { transpose_item(nsa_w_in, DM, NSA_N, WT_NSA, MapNsa(), scr, r, lane); continue; } r -= I_NSA;
            if (r < I_RWKV) { transpose_item(rwkv_w_in, DM, RWKV_N, WT_RWKV, MapId(), scr, r, lane); continue; } r -= I_RWKV;
            if (r < 2 * I_OUT) { const int l = r / I_OUT; transpose_item(w_out + (size_t)l * DM * DM, DM, DM, WT_OUT + (size_t)l * DM * DM, MapId(), scr, r % I_OUT, lane); continue; } r -= 2 * I_OUT;
            if (r < 2 * I_FIN) { const int l = r / I_FIN; transpose_item(w_ffn_in + (size_t)l * DM * FFN_N2, DM, FFN_N2, WT_FIN + (size_t)l * DM * FFN_N2, MapFfn(), scr, r % I_FIN, lane); continue; } r -= 2 * I_FIN;
            if (r < 2 * I_FOUT) { const int l = r / I_FOUT; transpose_item(w_ffn_out + (size_t)l * FFN_H * DM, FFN_H, DM, WT_FOUT + (size_t)l * FFN_H * DM, MapId(), scr, r % I_FOUT, lane); continue; } r -= 2 * I_FOUT;
            if (r < I_C1) { transpose_item(cmp_k_w1, 2048, 256, WT_C1K, MapId(), scr, r, lane); continue; } r -= I_C1;
            if (r < I_C1) { transpose_item(cmp_v_w1, 2048, 256, WT_C1V, MapId(), scr, r, lane); continue; } r -= I_C1;
            transpose_item(w_mem_kv, DM, 512, WT_MKV, MapId(), scr, r, lane);
        }
        for (int i = gtid; i < (NSA_NP - NSA_N) * DM / 8; i += NGT) ((u32x4*)(WT_NSA + (size_t)NSA_N * DM))[i] = (u32x4){0u, 0u, 0u, 0u};
        for (int i = gtid; i < MTOK * 8; i += NGT) { const int row = i >> 3, k = i & 7;
            const float inv = (k == 0) ? 1.0f : (k == 1) ? 0.1939227432012558f : (k == 2) ? 0.03760603070259094f : (k == 3) ? 0.007292664609849453f : (k == 4) ? 0.0014142135623842478f : (k == 5) ? 0.00027424818836152554f : (k == 6) ? 5.318296098266728e-05f : 1.0313386155758053e-05f;
            const float ang = (float)positions[row] * inv; COS[i] = cosf(ang); SIN[i] = sinf(ang); }
        if (gtid < 512) { const int hh = gtid & 255; const float* pos = gtid < 256 ? cmp_pos_k : cmp_pos_v; const float* w1 = gtid < 256 ? cmp_k_w1 : cmp_v_w1; float s = 0.f;
            for (int k = 0; k < 2048; ++k) s += pos[k] * w1[(size_t)k * 256 + hh];
            (gtid < 256 ? BIASK : BIASV)[hh] = s; }
        for (int m = gw; m < MTOK; m += NGW) rms_row_to_bf16(XIN + (size_t)m * DM, pre_mix_g, HN_A + (size_t)m * DM, lane);
        for (int m = gw; m < BATCH * NMEM; m += NGW) rms_row_to_bf16(MEMIN + (size_t)m * DM, mem_norm_g, MEMN + (size_t)m * DM, lane);
    }
    grid.sync();

    {
        { pg8::Gemm g{MEMN, WT_MKV, BATCH * NMEM, 512, DM, DM}; pg8::StaticOrder S; S.init(g.M, g.N, G, bid); pg8::EpiBf16 E{MKV, 512};
          pg8::gemm_phase<pg8::EpiBf16, true>(lds, g, S, E); }
        { pg8::Gemm g{HN_A, WT_NSA, MTOK, NSA_NP, DM, DM}; pg8::StaticOrder S; S.init(g.M, g.N, G, bid); pg8::EpiNsaSplit E{Qb, KV6, QM, GATES, nsa_gate_b};
          pg8::gemm_phase<pg8::EpiNsaSplit, true>(lds, g, S, E); }
    }
    grid.sync();

    {
        { pg8::Gemm g{KV6, WT_C1K, 3072, 256, 2048, 1024}; pg8::StaticOrder S; S.init(g.M, g.N, G, bid); pg8::EpiGeluBias E{CMPHK, 256, BIASK};
          pg8::gemm_phase<pg8::EpiGeluBias, true>(lds, g, S, E); }
        { pg8::Gemm g{KV6 + KV6_STRIDE, WT_C1V, 3072, 256, 2048, 1024}; pg8::StaticOrder S; S.init(g.M, g.N, G, bid); pg8::EpiGeluBias E{CMPHV, 256, BIASV};
          pg8::gemm_phase<pg8::EpiGeluBias, true>(lds, g, S, E); }
        for (int i = gtid; i < MTOK * 18 * 8; i += NGT) { const int k = i & 7, slot = (i >> 3) % 18, row = i / 144;
            bf16_t* p;
            if (slot < 12) p = Qb + (size_t)row * 768 + slot * 64;
            else { const int s2 = slot - 12, which = s2 / 3, gg = s2 % 3, b = row >> 13, s = row & 8191; p = KV6 + (size_t)(which == 0 ? 2 : 4) * KV6_STRIDE + ((size_t)(b * 3 + gg) * SEQ + s) * HD; }
            const float c = COS[row * 8 + k], sn = SIN[row * 8 + k]; const float t1 = bf2f(p[k]), t2 = bf2f(p[8 + k]);
            p[k] = (bf16_t)f2bf(t1 * c - t2 * sn); p[8 + k] = (bf16_t)f2bf(t1 * sn + t2 * c); }
    }
    grid.sync();

    {
        for (int it = gw; it < 2 * 3072; it += NGW) { const int kv = it / 3072, m = it % 3072, n = m & 511, bgi = m >> 9, b = bgi / 3;
            const bf16_t* hrow = (kv ? CMPHV : CMPHK) + (size_t)m * 256; const float* w2 = kv ? cmp_v_w2 : cmp_k_w2;
            float s = 0.f;
            for (int hh = 0; hh < 256; ++hh) s += bf2f(hrow[hh]) * w2[hh * 64 + lane];
            if (kv == 0) { const float other = __shfl(s, lane ^ 8);
                if (lane < 16 && n < 511) { const int prow = b * SEQ + 16 * n + 31; const float c = COS[prow * 8 + (lane & 7)], sn = SIN[prow * 8 + (lane & 7)];
                    s = (lane < 8) ? (s * c - other * sn) : (other * sn + s * c); } }
            if (n >= 511) s = 0.f;
            (kv ? VC : KC)[(size_t)m * 64 + lane] = (bf16_t)f2bf(s); }
    }
    grid.sync();

    {
        LAS unsigned char* wl = lds + wave * 17984;
        NsaPtrs P{Qb, KV6, KC, VC, GATES, OA};
        for (int it = gw; it < MTOK * 3; it += NGW) nsa_item(P, it, wl, lane);
        for (int row = gw; row < MTOK; row += NGW) mem_item(QM + (size_t)row * 256, MKV, OA + (size_t)row * 1024 + 768, row >> 13, wl, lane);
    }
    grid.sync();

#pragma unroll
    for (int layer = 0; layer < 2; ++layer) {
        if (layer == 1) {
            { pg8::Gemm g{HN_B, WT_RWKV, MTOK, RWKV_N, DM, DM}; pg8::StaticOrder S; S.init(g.M, g.N, G, bid); pg8::EpiBf16 E{PROJ1, RWKV_N};
              pg8::gemm_phase<pg8::EpiBf16, true>(lds, g, S, E); }
            grid.sync();
            {
                LAS unsigned char* wl = lds + wave * 17984;
                for (int row = gw; row < MTOK; row += NGW) mem_item(PROJ1 + (size_t)row * RWKV_N + 2560, MKV, OA + (size_t)row * 1024 + 768, row >> 13, wl, lane);
                __syncthreads();
                if (bid < 24) { RwkvPtrs P{PROJ1, a.in[21], a.in[22], a.in[23], a.in[24], a.in[25], a.in[26], a.in[27], a.in[28], a.in[29], a.in[30], a.in[31], OA};
                    rwkv_unit(P, bid / 12, bid % 12, lds, tid); }
            }
            grid.sync();
        }
        float* MIX = (float*)(a.ws + (layer == 0 ? WS_MIX0 : WS_MIX1));
        { pg8::Gemm g{OA, WT_OUT + (size_t)layer * DM * DM, MTOK, DM, DM, DM}; pg8::StaticOrder S; S.init(g.M, g.N, G, bid); pg8::EpiF32 E{MIX, DM};
          pg8::gemm_phase<pg8::EpiF32, true>(lds, g, S, E); }
        grid.sync();
        for (int m = gw; m < MTOK; m += NGW) res_row((layer == 0 ? XIN : OUTP) + (size_t)m * DM, MIX + (size_t)m * DM, post_mix_g + layer * DM, pre_ffn_g + layer * DM, OUTP + (size_t)m * DM, HN_A + (size_t)m * DM, lane);
        grid.sync();
        { pg8::Gemm g{HN_A, WT_FIN + (size_t)layer * DM * FFN_N2, MTOK, FFN_N2, DM, DM}; pg8::StaticOrder S; S.init(g.M, g.N, G, bid); pg8::EpiSwiglu E{ACT, FFN_H};
          pg8::gemm_phase<pg8::EpiSwiglu, true>(lds, g, S, E); }
        grid.sync();
        { pg8::Gemm g{ACT, WT_FOUT + (size_t)layer * FFN_H * DM, MTOK, DM, FFN_H, FFN_H}; pg8::StaticOrder S; S.init(g.M, g.N, G, bid); pg8::EpiF32 E{FF, DM};
          pg8::gemm_phase<pg8::EpiF32, true>(lds, g, S, E); }
        grid.sync();
        for (int m = gw; m < MTOK; m += NGW) res_row(OUTP + (size_t)m * DM, FF + (size_t)m * DM, post_ffn_g + layer * DM, layer == 0 ? pre_mix_g + DM : nullptr, OUTP + (size_t)m * DM, layer == 0 ? HN_B + (size_t)m * DM : nullptr, lane);
        if (layer == 0) grid.sync();
    }
}

extern "C" void kernel_launch(void* const* d_in, const int* in_sizes, int n_in, void* d_out, int out_size, void* d_ws, size_t ws_size, hipStream_t stream) {
    static int grid = 0;
    if (grid == 0) {
        int dev = 0, cus = 0, per_cu = 0;
        hipGetDevice(&dev);
        hipDeviceGetAttribute(&cus, hipDeviceAttributeMultiprocessorCount, dev);
        hipFuncSetAttribute((const void*)fwd_kernel, hipFuncAttributeMaxDynamicSharedMemorySize, LDS_BYTES);
        hipOccupancyMaxActiveBlocksPerMultiprocessor(&per_cu, (const void*)fwd_kernel, NTHREADS, LDS_BYTES);
        if (per_cu < 1) { fprintf(stderr, "kernel_launch: occupancy query says %d blocks per CU\n", per_cu); per_cu = 1; }
        (void)hipGetLastError();
        grid = cus;
        if (n_in != 32) fprintf(stderr, "kernel_launch: expected 32 inputs, got %d\n", n_in);
    }
    Args a{};
    for (int i = 0; i < 32; ++i) a.in[i] = (const float*)d_in[i];
    a.out = (float*)d_out; a.ws = (unsigned char*)d_ws;
    void* args[] = {&a};
    hipError_t e = hipLaunchCooperativeKernel((const void*)fwd_kernel, dim3(grid), dim3(NTHREADS), args, LDS_BYTES, stream);
    if (e != hipSuccess) fprintf(stderr, "cooperative launch failed: %s (grid %d)\n", hipGetErrorString(e), grid);
}
```

```cpp
#include <hip/hip_runtime.h>
#include <hip/hip_cooperative_groups.h>
#include <cstdio>
#include <cstdint>
namespace cg = cooperative_groups;

#define LAS __attribute__((address_space(3)))
typedef unsigned short bf16_t;
typedef short bf16x8 __attribute__((ext_vector_type(8)));
typedef float f32x4 __attribute__((ext_vector_type(4)));
typedef float f32x2 __attribute__((ext_vector_type(2)));
typedef unsigned u32x4 __attribute__((ext_vector_type(4)));
typedef unsigned u32x2 __attribute__((ext_vector_type(2)));

constexpr int BATCH = 2, SEQ = 8192, MTOK = BATCH * SEQ, DM = 1024;
constexpr int NMEM = 256, HD = 64;
constexpr int NSA_N = 2212, NSA_NP = 2304;
constexpr int RWKV_N = 2816, FFN_H = 2816, FFN_N2 = 5632;
constexpr int PRIM = 768;
constexpr float NORM_EPS = 1e-6f;
constexpr int NTHREADS = 512, NWAVES = 8;
constexpr int LDS_BYTES = 147456;

constexpr size_t MiB = 1u << 20;
constexpr size_t WS_WT_NSA = 1 * MiB, WS_WT_RWKV = 6 * MiB, WS_WT_OUT = 12 * MiB, WS_WT_FIN = 16 * MiB, WS_WT_FOUT = 38 * MiB;
constexpr size_t WS_WT_C1K = 49 * MiB, WS_WT_C1V = 50 * MiB, WS_WT_MKV = 51 * MiB;
constexpr size_t WS_MEMN = 52 * MiB, WS_MKV = 53 * MiB, WS_COS = 53 * MiB + 512 * 1024, WS_SIN = 54 * MiB;
constexpr size_t WS_KC = 54 * MiB + 512 * 1024, WS_VC = 55 * MiB, WS_BIASK = 55 * MiB + 512 * 1024, WS_BIASV = WS_BIASK + 4096;
constexpr size_t WS_MVT = 55 * MiB + 576 * 1024;
constexpr size_t WS_W2T = 62 * MiB, WS_A2T = 62 * MiB + 128 * 1024, WS_G2T = 62 * MiB + 256 * 1024;
constexpr size_t WS_RKM = 64 * MiB, WS_RKG = 216 * MiB;
constexpr size_t WS_GATES = 56 * MiB, WS_CMPHK = 59 * MiB, WS_CMPHV = 60 * MiB + 512 * 1024;
constexpr size_t WS_HN_A = 64 * MiB, WS_OA = 96 * MiB, WS_FF = 64 * MiB;
constexpr size_t WS_Q = 128 * MiB, WS_KV6 = 152 * MiB, WS_QM = 188 * MiB;
constexpr size_t WS_MIX0 = 192 * MiB, WS_MIX1 = 128 * MiB, WS_ACT = 128 * MiB, WS_HN_B = 216 * MiB, WS_PROJ1 = 128 * MiB;
constexpr size_t KV6_STRIDE = (size_t)BATCH * 3 * SEQ * HD;

__device__ __forceinline__ unsigned f2bf(float f) { unsigned u = __builtin_bit_cast(unsigned, f); return (u + 0x7fffu + ((u >> 16) & 1u)) >> 16; }
__device__ __forceinline__ unsigned pk2(float lo, float hi) { return f2bf(lo) | (f2bf(hi) << 16); }
__device__ __forceinline__ float bf_lo(unsigned u) { return __builtin_bit_cast(float, u << 16); }
__device__ __forceinline__ float bf_hi(unsigned u) { return __builtin_bit_cast(float, u & 0xffff0000u); }
__device__ __forceinline__ float bf2f(bf16_t h) { return __builtin_bit_cast(float, (unsigned)h << 16); }
__device__ __forceinline__ float wave_sum(float v) {
#pragma unroll
    for (int o = 1; o < 64; o <<= 1) v += __shfl_xor(v, o);
    return v;
}
__device__ __forceinline__ float wave_max(float v) {
#pragma unroll
    for (int o = 1; o < 64; o <<= 1) v = fmaxf(v, __shfl_xor(v, o));
    return v;
}
__device__ __forceinline__ float sigmoidf_(float x) { return 1.0f / (1.0f + __expf(-x)); }
__device__ __forceinline__ float gelu_tanh(float x) { return 0.5f * x * (1.0f + tanhf(0.7978845608028654f * (x + 0.044715f * x * x * x))); }
#define LDS_FENCE() asm volatile("s_waitcnt lgkmcnt(0)" ::: "memory")

namespace pg8 {
constexpr int BM = 256, BK = 64, HALF = 128, HTB = HALF * BK * 2, STAGE_BYTES = 8 * HTB, NXCD = 8, WGM = 8;
__host__ __device__ __forceinline__ int lds_byte(int r, int c) { const int st = (r >> 4) * 2 + (c >> 5), rr = r & 15, cc = c & 31, ob = rr * 64 + cc * 2; return st * 1024 + (ob ^ (((ob >> 9) & 1) << 5)); }
__host__ __device__ __forceinline__ void stage_rc(int b, int& R, int& C) { const int st = b / 1024, sb = b % 1024, swz = sb ^ (((sb >> 9) & 1) << 5); R = (st >> 1) * 16 + swz / 64; C = (st & 1) * 32 + (swz % 64) / 2; }
__host__ __device__ __forceinline__ int perm32(int rho) { const int n = rho >> 4, i = rho & 15; return 8 * (i >> 2) + 4 * n + (i & 3); }

struct Unit { int pm, pn; };
struct Gemm { const bf16_t* A; const bf16_t* Bt; int M, N, K, lda; };

struct StaticOrder {
    int nM, nN, nwg, G, c;
    __device__ void init(int M, int N, int G_, int c_) { nM = M / BM; nN = N / BM; nwg = nM * nN; G = G_; c = c_; }
    __device__ bool next(int i, Unit& u) const {
        const long L = (long)i * G + c; if (L >= nwg) return false;
        int wgid = (int)L; { const int q = nwg / NXCD, r = nwg % NXCD, xcd = wgid % NXCD, off = wgid / NXCD; wgid = (xcd < r ? xcd * (q + 1) : r * (q + 1) + (xcd - r) * q) + off; }
        const int nig = WGM * nN, gid = wgid / nig, fm = gid * WGM, gsz = (nM - fm) < WGM ? (nM - fm) : WGM;
        u.pm = fm + ((wgid % nig) % gsz); u.pn = (wgid % nig) / gsz; return true;
    }
};

template <class Epi, bool ALIGN_EPI>
__device__ __forceinline__ void gemm_phase(LAS unsigned char* lds, const Gemm g, const StaticOrder& S, const Epi& E) {
    int tid_ = threadIdx.x; asm volatile("" : "+v"(tid_));
    const int tid = tid_, wid = __builtin_amdgcn_readfirstlane(tid >> 6), lane = tid & 63, wr = wid >> 2, wc = wid & 3, fr = lane & 15, fq = lane >> 4;
    const int K = g.K, nt = K / BK, lda = g.lda;
    unsigned voffA[2], voffB[2];
#pragma unroll
    for (int i = 0; i < 2; ++i) { int R, C; stage_rc(tid * 16 + i * 8192, R, C); const int Rb = Epi::PERM ? ((R & ~31) + perm32(R & 31)) : R;
        voffA[i] = (unsigned)(R * lda + C) * 2u; voffB[i] = (unsigned)(Rb * K + C) * 2u; }
    const size_t kstep = (size_t)(BK * 2);
    const size_t hstepA = (size_t)HALF * lda * 2, hstepB = (size_t)HALF * K * 2;
    const size_t tstepA = 2 * hstepA, tstepB = 2 * hstepB;
    const unsigned ldsw = (unsigned)wid * 1024u;
    const int aoff = lds_byte(wr * 64 + fr, fq * 8), boff = lds_byte(wc * 32 + fr, fq * 8);
#define PG8_SA(b, h) (((b) * 2 + (h)) * HTB)
#define PG8_SB(b, h) ((4 + (b) * 2 + (h)) * HTB)
#define PG8_STAGE(bufoff, gbase, voff) do { _Pragma("unroll") for (int _i = 0; _i < 2; ++_i) \
        __builtin_amdgcn_global_load_lds((const unsigned*)((const char*)(gbase) + (voff)[_i]), (LAS unsigned*)(lds + (bufoff) + ldsw + _i * 8192), 16, 0, 0); } while (0)
#define PG8_LDA(dst, b, h) do { _Pragma("unroll") for (int m = 0; m < 4; ++m) _Pragma("unroll") for (int k = 0; k < 2; ++k) dst[m][k] = *(const LAS bf16x8*)(lds + PG8_SA(b, h) + aoff + m * 2048 + k * 1024); } while (0)
#define PG8_LDB(dst, b, h) do { _Pragma("unroll") for (int n = 0; n < 2; ++n) _Pragma("unroll") for (int k = 0; k < 2; ++k) dst[n][k] = *(const LAS bf16x8*)(lds + PG8_SB(b, h) + boff + n * 2048 + k * 1024); } while (0)
#define PG8_MMA(ai, bj, At, Bt) do { __builtin_amdgcn_s_setprio(1); _Pragma("unroll") for (int m = 0; m < 4; ++m) _Pragma("unroll") for (int n = 0; n < 2; ++n) _Pragma("unroll") for (int k = 0; k < 2; ++k) \
        acc[ai][bj][m][n] = __builtin_amdgcn_mfma_f32_16x16x32_bf16(Bt[n][k], At[m][k], acc[ai][bj][m][n], 0, 0, 0); __builtin_amdgcn_s_setprio(0); } while (0)
#define PG8_WAIT_V(n) asm volatile("s_waitcnt vmcnt(" #n ")" ::: "memory")
#define PG8_WAIT_L(n) asm volatile("s_waitcnt lgkmcnt(" #n ")" ::: "memory")
#define PG8_BAR __builtin_amdgcn_s_barrier()
#define PG8_SCHED __builtin_amdgcn_sched_barrier(0)
    Unit cur, nxt; int ui = 0;
    if (!S.next(0, cur)) return;
    f32x4 acc[2][2][4][2];
#pragma unroll
    for (int a = 0; a < 2; ++a)
#pragma unroll
        for (int b = 0; b < 2; ++b)
#pragma unroll
            for (int m = 0; m < 4; ++m)
#pragma unroll
                for (int n = 0; n < 2; ++n) acc[a][b][m][n] = (f32x4){0.f, 0.f, 0.f, 0.f};
    bf16x8 At[4][2], B0[2][2], B1[2][2];
    const char* cA = (const char*)g.A + (size_t)cur.pm * tstepA; const char* cB = (const char*)g.Bt + (size_t)cur.pn * tstepB;
    PG8_STAGE(PG8_SB(0, 0), cB, voffB); PG8_STAGE(PG8_SB(0, 1), cB + hstepB, voffB); PG8_STAGE(PG8_SA(0, 0), cA, voffA); PG8_STAGE(PG8_SA(0, 1), cA + hstepA, voffA);
    if (wr == 1) PG8_BAR;
    PG8_WAIT_V(2); PG8_BAR;
    PG8_STAGE(PG8_SB(1, 0), cB + kstep, voffB); PG8_STAGE(PG8_SA(1, 0), cA + kstep, voffA); PG8_STAGE(PG8_SB(1, 1), cB + hstepB + kstep, voffB);
    PG8_WAIT_V(6); PG8_BAR;
    for (;;) {
        const bool has_next = S.next(ui + 1, nxt);
        const char* nA = has_next ? (const char*)g.A + (size_t)nxt.pm * tstepA : cA; const char* nB = has_next ? (const char*)g.Bt + (size_t)nxt.pn * tstepB : cB;
        for (int t = 0; t < nt; t += 2) {
            const bool last = (t == nt - 2);
            const char* a1 = cA + (size_t)(t + 1) * kstep;
            const char* a2 = last ? nA : cA + (size_t)(t + 2) * kstep; const char* b2 = last ? nB : cB + (size_t)(t + 2) * kstep;
            const char* a3 = a2 + kstep; const char* b3 = b2 + kstep;
            PG8_LDB(B0, 0, 0); PG8_LDB(B1, 0, 1); PG8_SCHED; PG8_LDA(At, 0, 0); PG8_STAGE(PG8_SA(1, 1), a1 + hstepA, voffA);
            PG8_WAIT_V(8); PG8_WAIT_L(0); PG8_BAR; PG8_MMA(0, 0, At, B0); PG8_MMA(0, 1, At, B1); PG8_BAR; PG8_SCHED;
            PG8_LDA(At, 0, 1); PG8_STAGE(PG8_SB(0, 0), b2, voffB); PG8_STAGE(PG8_SB(0, 1), b2 + hstepB, voffB); PG8_STAGE(PG8_SA(0, 0), a2, voffA);
            PG8_WAIT_V(8); PG8_WAIT_L(0); PG8_BAR; PG8_MMA(1, 0, At, B0); PG8_MMA(1, 1, At, B1); PG8_BAR; PG8_SCHED;
            PG8_LDB(B0, 1, 0); PG8_LDB(B1, 1, 1); PG8_SCHED; PG8_LDA(At, 1, 0); PG8_STAGE(PG8_SA(0, 1), a2 + hstepA, voffA);
            PG8_WAIT_V(8); PG8_WAIT_L(0); PG8_BAR; PG8_MMA(0, 0, At, B0); PG8_MMA(0, 1, At, B1); PG8_BAR; PG8_SCHED;
            PG8_LDA(At, 1, 1); PG8_STAGE(PG8_SB(1, 0), b3, voffB); PG8_STAGE(PG8_SB(1, 1), b3 + hstepB, voffB); PG8_STAGE(PG8_SA(1, 0), a3, voffA);
            PG8_WAIT_V(8); PG8_WAIT_L(0); PG8_BAR; PG8_MMA(1, 0, At, B0); PG8_MMA(1, 1, At, B1); PG8_BAR; PG8_SCHED;
        }
        if constexpr (ALIGN_EPI) { if (wr == 0) PG8_BAR; }
        { int fr2 = fr, fq2 = fq; asm volatile("" : "+v"(fr2), "+v"(fq2)); E(acc, cur, wr, wc, fr2, fq2); }
        if (!has_next) break;
#pragma unroll
        for (int a = 0; a < 2; ++a)
#pragma unroll
            for (int b = 0; b < 2; ++b)
#pragma unroll
                for (int m = 0; m < 4; ++m)
#pragma unroll
                    for (int n = 0; n < 2; ++n) acc[a][b][m][n] = (f32x4){0.f, 0.f, 0.f, 0.f};
        cur = nxt; cA = nA; cB = nB; ++ui;
        if constexpr (ALIGN_EPI) { if (wr == 1) PG8_BAR; }
    }
    PG8_WAIT_V(0);
    if constexpr (!ALIGN_EPI) { if (wr == 0) PG8_BAR; }
    PG8_BAR;
#undef PG8_SA
#undef PG8_SB
#undef PG8_STAGE
#undef PG8_LDA
#undef PG8_LDB
#undef PG8_MMA
#undef PG8_WAIT_V
#undef PG8_WAIT_L
#undef PG8_BAR
#undef PG8_SCHED
}

struct EpiBf16 {
    static constexpr bool PERM = true;
    bf16_t* O; int ldc;
    __device__ __forceinline__ void operator()(const f32x4 (&acc)[2][2][4][2], const Unit& u, int wr, int wc, int fr, int fq) const {
        const int row0 = u.pm * BM + wr * 64 + fr, col0 = u.pn * BM + wc * 32 + 8 * fq;
#pragma unroll
        for (int ai = 0; ai < 2; ++ai)
#pragma unroll
            for (int m = 0; m < 4; ++m) { bf16_t* rowp = O + (size_t)(row0 + ai * HALF + m * 16) * ldc + col0;
#pragma unroll
                for (int bj = 0; bj < 2; ++bj) { const f32x4 v0 = acc[ai][bj][m][0], v1 = acc[ai][bj][m][1];
                    u32x4 w; w.x = pk2(v0[0], v0[1]); w.y = pk2(v0[2], v0[3]); w.z = pk2(v1[0], v1[1]); w.w = pk2(v1[2], v1[3]);
                    *(u32x4*)(rowp + bj * HALF) = w; } }
    }
};
struct EpiGeluBias {
    static constexpr bool PERM = true;
    bf16_t* O; int ldc; const float* bias;
    __device__ __forceinline__ void operator()(const f32x4 (&acc)[2][2][4][2], const Unit& u, int wr, int wc, int fr, int fq) const {
        const int row0 = u.pm * BM + wr * 64 + fr, col0 = u.pn * BM + wc * 32 + 8 * fq;
#pragma unroll
        for (int bj = 0; bj < 2; ++bj) {
            const f32x4 b0 = *(const f32x4*)(bias + col0 + bj * HALF), b1 = *(const f32x4*)(bias + col0 + bj * HALF + 4);
#pragma unroll
            for (int ai = 0; ai < 2; ++ai)
#pragma unroll
                for (int m = 0; m < 4; ++m) { bf16_t* rowp = O + (size_t)(row0 + ai * HALF + m * 16) * ldc + col0 + bj * HALF;
                    const f32x4 v0 = acc[ai][bj][m][0] + b0, v1 = acc[ai][bj][m][1] + b1;
                    u32x4 w; w.x = pk2(gelu_tanh(v0[0]), gelu_tanh(v0[1])); w.y = pk2(gelu_tanh(v0[2]), gelu_tanh(v0[3]));
                    w.z = pk2(gelu_tanh(v1[0]), gelu_tanh(v1[1])); w.w = pk2(gelu_tanh(v1[2]), gelu_tanh(v1[3]));
                    *(u32x4*)rowp = w; } }
    }
};
struct EpiSwiglu {
    static constexpr bool PERM = true;
    bf16_t* O; int ldc;
    __device__ __forceinline__ void operator()(const f32x4 (&acc)[2][2][4][2], const Unit& u, int wr, int wc, int fr, int fq) const {
        const int row0 = u.pm * BM + wr * 64 + fr, col0 = u.pn * HALF + wc * 32 + 8 * fq;
#pragma unroll
        for (int ai = 0; ai < 2; ++ai)
#pragma unroll
            for (int m = 0; m < 4; ++m) { bf16_t* rowp = O + (size_t)(row0 + ai * HALF + m * 16) * ldc + col0;
                float r[8];
#pragma unroll
                for (int n = 0; n < 2; ++n)
#pragma unroll
                    for (int i = 0; i < 4; ++i) { const float gg = acc[ai][0][m][n][i], uu = acc[ai][1][m][n][i]; r[n * 4 + i] = gg / (1.0f + __expf(-gg)) * uu; }
                u32x4 w; w.x = pk2(r[0], r[1]); w.y = pk2(r[2], r[3]); w.z = pk2(r[4], r[5]); w.w = pk2(r[6], r[7]);
                *(u32x4*)rowp = w; }
    }
};
struct EpiF32 {
    static constexpr bool PERM = false;
    float* O; int ldc;
    __device__ __forceinline__ void operator()(const f32x4 (&acc)[2][2][4][2], const Unit& u, int wr, int wc, int fr, int fq) const {
        const int col0 = u.pn * BM + wc * 32 + 4 * fq;
#pragma unroll
        for (int ai = 0; ai < 2; ++ai)
#pragma unroll
            for (int m = 0; m < 4; ++m) { const int r = ai * HALF + wr * 64 + m * 16 + fr; float* rowp = O + (size_t)(u.pm * BM + r) * ldc + col0;
#pragma unroll
                for (int bj = 0; bj < 2; ++bj)
#pragma unroll
                    for (int n = 0; n < 2; ++n) *(f32x4*)(rowp + bj * HALF + n * 16) = acc[ai][bj][m][n]; }
    }
};
struct EpiNsaSplit {
    static constexpr bool PERM = true;
    bf16_t* Q; bf16_t* KV6; bf16_t* QM; float* GATES; const float* gate_b;
    __device__ __forceinline__ void operator()(const f32x4 (&acc)[2][2][4][2], const Unit& u, int wr, int wc, int fr, int fq) const {
        const int row0 = u.pm * BM + wr * 64 + fr;
#pragma unroll
        for (int bj = 0; bj < 2; ++bj) {
            const int c = u.pn * BM + bj * HALF + wc * 32 + 8 * fq;
#pragma unroll
            for (int ai = 0; ai < 2; ++ai)
#pragma unroll
                for (int m = 0; m < 4; ++m) {
                    const int row = row0 + ai * HALF + m * 16;
                    const f32x4 v0 = acc[ai][bj][m][0], v1 = acc[ai][bj][m][1];
                    if (c < 2176) {
                        bf16_t* dst;
                        if (c < 768) dst = Q + (size_t)row * 768 + c;
                        else if (c < 1920) { const int cc = c - 768, idx = cc / 192, rem = cc % 192, gg = rem >> 6, d = rem & 63, b = row >> 13, s = row & 8191;
                            if (idx == 3 || idx == 5) {
                                bf16_t* tp = KV6 + (size_t)idx * KV6_STRIDE + ((size_t)(b * 3 + gg) * HD + d) * SEQ + s;
#pragma unroll
                                for (int e = 0; e < 8; ++e) tp[(size_t)e * SEQ] = (bf16_t)f2bf(e < 4 ? v0[e & 3] : v1[e & 3]);
                                continue; }
                            dst = KV6 + (size_t)idx * KV6_STRIDE + ((size_t)(b * 3 + gg) * SEQ + s) * HD + d; }
                        else dst = QM + (size_t)row * 256 + (c - 1920);
                        u32x4 w; w.x = pk2(v0[0], v0[1]); w.y = pk2(v0[2], v0[3]); w.z = pk2(v1[0], v1[1]); w.w = pk2(v1[2], v1[3]);
                        *(u32x4*)dst = w;
                    } else if (c < 2212) {
#pragma unroll
                        for (int e = 0; e < 8; ++e) { const int cgi = c - 2176 + e; const float v = e < 4 ? v0[e & 3] : v1[e & 3];
                            if (cgi < 36) GATES[(size_t)row * 36 + cgi] = sigmoidf_(v + gate_b[cgi]); }
                    }
                }
        }
    }
};
}

struct Args { const float* in[32]; float* out; unsigned char* ws; };

template <class RowMap>
__device__ __forceinline__ void transpose_item(const float* W, int K, int N, bf16_t* WT, const RowMap& rm, LAS float* scr, int item, int lane) {
    const int nblk = (N + 31) / 32, kb = item / nblk, nb = item % nblk, k0 = 64 * kb, n0 = 32 * nb;
    const int nn = n0 + (lane & 31);
#pragma unroll 8
    for (int i = 0; i < 32; ++i) { const int kk = 2 * i + (lane >> 5); scr[kk * 33 + (lane & 31)] = (nn < N) ? W[(size_t)(k0 + kk) * N + nn] : 0.f; }
    LDS_FENCE();
    const int c = lane & 7;
#pragma unroll
    for (int j = 0; j < 4; ++j) { const int n = (lane >> 3) + 8 * j; const LAS float* s = scr + (8 * c) * 33 + n;
        u32x4 o; o.x = pk2(s[0 * 33], s[1 * 33]); o.y = pk2(s[2 * 33], s[3 * 33]); o.z = pk2(s[4 * 33], s[5 * 33]); o.w = pk2(s[6 * 33], s[7 * 33]);
        if (n0 + n < N) *(u32x4*)(WT + (size_t)rm(n0 + n) * K + k0 + 8 * c) = o; }
    LDS_FENCE();
}
struct MapId { __device__ __forceinline__ int operator()(int n) const { return n; } };
struct MapNsa { __device__ __forceinline__ int operator()(int n) const { return n < 1920 ? n : (n < 1956 ? n - 1920 + 2176 : n - 1956 + 1920); } };
struct MapFfn { __device__ __forceinline__ int operator()(int n) const { const int j = n < FFN_H ? n : n - FFN_H; return (j >> 7) * 256 + (n < FFN_H ? 0 : 128) + (j & 127); } };

__device__ __forceinline__ void rms_row_to_bf16(const float* xrow, const float* g, bf16_t* orow, int lane) {
    const f32x4* xr = (const f32x4*)xrow + lane; const f32x4* gr = (const f32x4*)g + lane;
    f32x4 v[4]; float s = 0.f;
#pragma unroll
    for (int j = 0; j < 4; ++j) { v[j] = xr[64 * j]; s += (v[j].x * v[j].x + v[j].y * v[j].y) + (v[j].z * v[j].z + v[j].w * v[j].w); }
    const float r = rsqrtf(wave_sum(s) * (1.f / DM) + NORM_EPS);
    u32x2* o8 = (u32x2*)orow + lane;
#pragma unroll
    for (int j = 0; j < 4; ++j) { const f32x4 gg = gr[64 * j]; u32x2 w; w.x = pk2(v[j].x * r * gg.x, v[j].y * r * gg.y); w.y = pk2(v[j].z * r * gg.z, v[j].w * r * gg.w); o8[64 * j] = w; }
}
__device__ __forceinline__ void res_row(const float* base, const float* y, const float* gpost, const float* gnext, float* out, bf16_t* hn, int lane) {
    const f32x4* yr = (const f32x4*)y + lane; const f32x4* br = (const f32x4*)base + lane; const f32x4* gp = (const f32x4*)gpost + lane;
    f32x4 v[4]; float s = 0.f;
#pragma unroll
    for (int j = 0; j < 4; ++j) { v[j] = yr[64 * j]; s += (v[j].x * v[j].x + v[j].y * v[j].y) + (v[j].z * v[j].z + v[j].w * v[j].w); }
    const float r = rsqrtf(wave_sum(s) * (1.f / DM) + NORM_EPS);
    float s2 = 0.f;
#pragma unroll
    for (int j = 0; j < 4; ++j) { const f32x4 gg = gp[64 * j], bb = br[64 * j]; v[j] = bb + v[j] * r * gg; s2 += (v[j].x * v[j].x + v[j].y * v[j].y) + (v[j].z * v[j].z + v[j].w * v[j].w); }
    f32x4* orow = (f32x4*)out + lane;
#pragma unroll
    for (int j = 0; j < 4; ++j) orow[64 * j] = v[j];
    if (hn) {
        const float r2 = rsqrtf(wave_sum(s2) * (1.f / DM) + NORM_EPS);
        const f32x4* gn = (const f32x4*)gnext + lane; u32x2* o8 = (u32x2*)hn + lane;
#pragma unroll
        for (int j = 0; j < 4; ++j) { const f32x4 gg = gn[64 * j]; u32x2 w; w.x = pk2(v[j].x * r2 * gg.x, v[j].y * r2 * gg.y); w.y = pk2(v[j].z * r2 * gg.z, v[j].w * r2 * gg.w); o8[64 * j] = w; }
    }
}

namespace att {
typedef float f32x16 __attribute__((ext_vector_type(16)));
constexpr int KSTR = 144, VSTR = 136, BUFB = 18432, VOFF = 9216;
constexpr int LDS_IMP = 2 * BUFB;
constexpr int LDS_SELM = LDS_IMP + 32768;
constexpr int LDS_MISC = LDS_SELM + 1024;
constexpr float C2 = 0.125f * 1.4426950408889634f;
constexpr float NEGBIG = -1e30f;

__device__ __forceinline__ int crow(int r, int hi) { return (r & 3) + 8 * (r >> 2) + 4 * hi; }
struct Src { const bf16_t* K; int kstride; const bf16_t* Vt; int vstride; };
struct Acc { float m, l; f32x16 o0, o1; };

__device__ __forceinline__ void tile_load(u32x4& kreg, u32x4& vreg, const Src& s, int key0, int tid, bool withV) {
    const int row = tid >> 3, ch = tid & 7;
    kreg = *(const u32x4*)(s.K + (size_t)(key0 + row) * s.kstride + ch * 8);
    if (withV) vreg = *(const u32x4*)(s.Vt + (size_t)row * s.vstride + key0 + ch * 8);
}
__device__ __forceinline__ void tile_store(LAS unsigned char* lds, int buf, const u32x4& kreg, const u32x4& vreg, int tid, bool withV) {
    const int row = tid >> 3, ch = tid & 7;
    *(LAS u32x4*)(lds + buf * BUFB + row * KSTR + ch * 16) = kreg;
    if (withV) { LAS u32x2* p = (LAS u32x2*)(lds + buf * BUFB + VOFF + row * VSTR + ch * 16); p[0] = (u32x2){vreg.x, vreg.y}; p[1] = (u32x2){vreg.z, vreg.w}; }
}
__device__ __forceinline__ void qk_tile(f32x16& S0, f32x16& S1, const LAS unsigned char* kl, const bf16x8 (&qr)[4], float bias, int r32, int hi) {
#pragma unroll
    for (int r = 0; r < 16; ++r) { S0[r] = bias; S1[r] = bias; }
    const LAS unsigned char* p = kl + r32 * KSTR + hi * 16;
#pragma unroll
    for (int d0 = 0; d0 < 4; ++d0) {
        const bf16x8 a0 = *(const LAS bf16x8*)(p + d0 * 32), a1 = *(const LAS bf16x8*)(p + 32 * KSTR + d0 * 32);
        S0 = __builtin_amdgcn_mfma_f32_32x32x16_bf16(a0, qr[d0], S0, 0, 0, 0);
        S1 = __builtin_amdgcn_mfma_f32_32x32x16_bf16(a1, qr[d0], S1, 0, 0, 0);
    }
}
__device__ __forceinline__ void mask_tile(f32x16& S0, f32x16& S1, int lo, int hi_, int hi) {
#pragma unroll
    for (int r = 0; r < 16; ++r) { const int kl = crow(r, hi);
        if (kl < lo || kl > hi_) S0[r] = -INFINITY;
        if (kl + 32 < lo || kl + 32 > hi_) S1[r] = -INFINITY; }
}
__device__ __forceinline__ float tile_max(const f32x16& S0, const f32x16& S1) {
    float a = fmaxf(S0[0], S1[0]);
#pragma unroll
    for (int r = 1; r < 16; ++r) a = fmaxf(a, fmaxf(S0[r], S1[r]));
    return fmaxf(a, __shfl_xor(a, 32));
}
__device__ __forceinline__ void pv_tile(f32x16& o0, f32x16& o1, const f32x16& S0, const f32x16& S1, const LAS unsigned char* vl, int r32, int hi) {
    bf16x8 pf[4];
#pragma unroll
    for (int s = 0; s < 4; ++s) { u32x4 w;
#pragma unroll
        for (int e = 0; e < 4; ++e) { const int r = (s & 1) * 8 + e * 2; w[e] = (s < 2) ? pk2(S0[r], S0[r + 1]) : pk2(S1[r], S1[r + 1]); }
        pf[s] = __builtin_bit_cast(bf16x8, w); }
    const LAS unsigned char* p = vl + r32 * VSTR + hi * 8;
#pragma unroll
    for (int s = 0; s < 4; ++s) {
        const u32x2 a0 = *(const LAS u32x2*)(p + s * 32), a1 = *(const LAS u32x2*)(p + s * 32 + 16);
        const u32x2 b0 = *(const LAS u32x2*)(p + 32 * VSTR + s * 32), b1 = *(const LAS u32x2*)(p + 32 * VSTR + s * 32 + 16);
        const bf16x8 va = __builtin_bit_cast(bf16x8, (u32x4){a0.x, a0.y, a1.x, a1.y}), vb = __builtin_bit_cast(bf16x8, (u32x4){b0.x, b0.y, b1.x, b1.y});
        o0 = __builtin_amdgcn_mfma_f32_32x32x16_bf16(va, pf[s], o0, 0, 0, 0);
        o1 = __builtin_amdgcn_mfma_f32_32x32x16_bf16(vb, pf[s], o1, 0, 0, 0);
    }
}
template <int MODE>
__device__ __forceinline__ void run_tiles(LAS unsigned char* lds, const Src& src, int tb, int te, const bf16x8 (&qr)[4], Acc& A, int tid, int r32, int hi, int ql, int aux, float invl) {
    constexpr bool withV = (MODE != 0);
    if (tb >= te) return;
    u32x4 kreg, vreg = (u32x4){0u, 0u, 0u, 0u};
    tile_load(kreg, vreg, src, tb * 64, tid, withV);
    for (int i = tb; i < te; ++i) {
        const int buf = i & 1;
        tile_store(lds, buf, kreg, vreg, tid, withV);
        if (i + 1 < te) tile_load(kreg, vreg, src, (i + 1) * 64, tid, withV);
        __syncthreads();
        float bias = 0.f; int lo = 0, hi_ = 63;
        if (MODE == 2) { if (i < aux) { const unsigned wb = ((const LAS unsigned*)(lds + LDS_SELM))[ql * 4 + (i >> 5)]; bias = ((wb >> (i & 31)) & 1u) ? 0.f : -INFINITY; } else hi_ = ql; }
        if (MODE == 3) { if (i == aux) hi_ = ql; if (i == aux - 8) lo = ql + 1; }
        if (MODE == 0 || MODE == 1) hi_ = aux - 64 * i;
        const bool skip = (MODE == 2) && __all(bias != 0.f);
        if (!skip) {
            f32x16 S0, S1;
            qk_tile(S0, S1, lds + buf * BUFB, qr, bias, r32, hi);
            if (!__all(lo <= 0 && hi_ >= 63)) mask_tile(S0, S1, lo, hi_, hi);
            if (MODE == 1) {
#pragma unroll
                for (int r = 0; r < 16; ++r) { S0[r] = __builtin_amdgcn_exp2f(S0[r] - A.m) * invl; S1[r] = __builtin_amdgcn_exp2f(S1[r] - A.m) * invl; }
                LAS float* imp = (LAS float*)(lds + LDS_IMP) + ql * 128;
#pragma unroll
                for (int rt = 0; rt < 2; ++rt)
#pragma unroll
                    for (int mg = 0; mg < 4; ++mg) {
                        const float p0 = rt ? S1[4 * mg] : S0[4 * mg], p1 = rt ? S1[4 * mg + 1] : S0[4 * mg + 1], p2 = rt ? S1[4 * mg + 2] : S0[4 * mg + 2], p3 = rt ? S1[4 * mg + 3] : S0[4 * mg + 3];
                        float av = 2.f * (p0 + p1 + p2) + p3, bv = p3;
                        av += __shfl_xor(av, 1); av += __shfl_xor(av, 2); bv += __shfl_xor(bv, 1); bv += __shfl_xor(bv, 2);
                        if ((r32 & 3) == 0) { const int j = (64 * i + 32 * rt + 8 * mg + 4 * hi) >> 2;
                            if (j < 128) { __hip_atomic_fetch_add(imp + j, av, __ATOMIC_RELAXED, __HIP_MEMORY_SCOPE_WORKGROUP);
                                if (j + 1 < 128) __hip_atomic_fetch_add(imp + j + 1, bv, __ATOMIC_RELAXED, __HIP_MEMORY_SCOPE_WORKGROUP); } }
                    }
                pv_tile(A.o0, A.o1, S0, S1, lds + buf * BUFB + VOFF, r32, hi);
            } else {
                const float rm = tile_max(S0, S1);
                const float mn = fmaxf(A.m, rm);
                const float alpha = __builtin_amdgcn_exp2f(A.m - mn);
                A.m = mn;
                float ls = 0.f;
#pragma unroll
                for (int r = 0; r < 16; ++r) { S0[r] = __builtin_amdgcn_exp2f(S0[r] - mn); S1[r] = __builtin_amdgcn_exp2f(S1[r] - mn); ls += S0[r] + S1[r]; }
                A.l = A.l * alpha + ls;
                if (MODE != 0) {
                    if (!__all(alpha == 1.0f)) {
#pragma unroll
                        for (int r = 0; r < 16; ++r) { A.o0[r] *= alpha; A.o1[r] *= alpha; } }
                    pv_tile(A.o0, A.o1, S0, S1, lds + buf * BUFB + VOFF, r32, hi);
                }
            }
        }
    }
    __syncthreads();
}
__device__ __forceinline__ void load_q(bf16x8 (&qr)[4], const bf16_t* qp) {
#pragma unroll
    for (int d0 = 0; d0 < 4; ++d0) { const u32x4 raw = *(const u32x4*)(qp + d0 * 16); u32x4 w;
#pragma unroll
        for (int e = 0; e < 4; ++e) w[e] = pk2(bf_lo(raw[e]) * C2, bf_hi(raw[e]) * C2);
        qr[d0] = __builtin_bit_cast(bf16x8, w); }
}
__device__ __forceinline__ void acc_reset(Acc& A) { A.m = NEGBIG; A.l = 0.f;
#pragma unroll
    for (int r = 0; r < 16; ++r) { A.o0[r] = 0.f; A.o1[r] = 0.f; } }
__device__ __forceinline__ void store_out(bf16_t* orow, const f32x16& o0, const f32x16& o1, int hi) {
#pragma unroll
    for (int rg = 0; rg < 4; ++rg) {
        *(u32x2*)(orow + 8 * rg + 4 * hi) = (u32x2){pk2(o0[4 * rg], o0[4 * rg + 1]), pk2(o0[4 * rg + 2], o0[4 * rg + 3])};
        *(u32x2*)(orow + 32 + 8 * rg + 4 * hi) = (u32x2){pk2(o1[4 * rg], o1[4 * rg + 1]), pk2(o1[4 * rg + 2], o1[4 * rg + 3])}; }
}

struct NsaP { const bf16_t* Q; const bf16_t* KV6; const bf16_t* KC; const bf16_t* VCt; const float* GATES; bf16_t* OA; };
__device__ __forceinline__ void nsa_unit(const NsaP& P, int b, int g, int blk, LAS unsigned char* lds, int tid) {
    asm volatile("" : "+v"(tid));
    const int lane = tid & 63, wave = __builtin_amdgcn_readfirstlane(tid >> 6), r32 = lane & 31, hi = lane >> 5;
    const int ql = 8 * wave + (r32 >> 2), hh = r32 & 3, t0 = blk * 64, t = t0 + ql, cur = blk;
    const size_t row = (size_t)b * SEQ + t, bg = (size_t)(b * 3 + g);
    bf16x8 qr[4]; load_q(qr, P.Q + row * 768 + (g * 4 + hh) * 64 + hi * 8);
    const float* gp = P.GATES + row * 36 + (g * 4 + hh) * 3; const float g0 = gp[0], g1 = gp[1], g2 = gp[2];
    f32x16 out0, out1;
#pragma unroll
    for (int r = 0; r < 16; ++r) { out0[r] = 0.f; out1[r] = 0.f; }
    { LAS f32x4* z = (LAS f32x4*)(lds + LDS_IMP);
#pragma unroll
      for (int i = 0; i < 4; ++i) z[tid + i * NTHREADS] = (f32x4){0.f, 0.f, 0.f, 0.f}; }
    Acc A;
    {
        const int nvmax = ((t0 >> 4) + 3) > 511 ? 511 : ((t0 >> 4) + 3), ntc = (nvmax + 63) >> 6;
        const int nlim = (t >= 31) ? ((t - 31) >> 4) : -1;
        const Src sc{P.KC + bg * 512 * 64, 64, P.VCt + bg * 64 * 512, 512};
        acc_reset(A);
        run_tiles<0>(lds, sc, 0, ntc, qr, A, tid, r32, hi, ql, nlim, 0.f);
        const float lt = A.l + __shfl_xor(A.l, 32);
        const float invl = lt > 0.f ? 1.0f / lt : 0.f;
        run_tiles<1>(lds, sc, 0, ntc, qr, A, tid, r32, hi, ql, nlim, invl);
#pragma unroll
        for (int r = 0; r < 16; ++r) { out0[r] = g0 * A.o0[r]; out1[r] = g0 * A.o1[r]; }
    }
    {
        LAS float* imp = (LAS float*)(lds + LDS_IMP); LAS unsigned* selm = (LAS unsigned*)(lds + LDS_SELM);
        for (int i = 0; i < 8; ++i) { const int q = 8 * wave + i; unsigned long long m0, m1;
            if (cur < 16) { m0 = (1ull << (cur + 1)) - 1ull; m1 = 0ull; }
            else {
                const float v0 = imp[q * 128 + lane], v1 = imp[q * 128 + 64 + lane]; int r0 = 0, r1 = 0; const int lo = 1, hi_ = cur - 2;
                for (int j = lo; j <= hi_; ++j) { const float v = imp[q * 128 + j]; r0 += (v > v0 || (v == v0 && j < lane)) ? 1 : 0; r1 += (v > v1 || (v == v1 && j < lane + 64)) ? 1 : 0; }
                const bool s0 = lane >= lo && lane <= hi_ && r0 < 13, s1 = (lane + 64) <= hi_ && r1 < 13;
                m0 = __ballot(s0); m1 = __ballot(s1);
                m0 |= 1ull;
                if (cur - 1 < 64) m0 |= 1ull << (cur - 1); else m1 |= 1ull << (cur - 1 - 64);
                if (cur < 64) m0 |= 1ull << cur; else m1 |= 1ull << (cur - 64);
            }
            if (lane == 0) { selm[q * 4 + 0] = (unsigned)m0; selm[q * 4 + 1] = (unsigned)(m0 >> 32); selm[q * 4 + 2] = (unsigned)m1; selm[q * 4 + 3] = (unsigned)(m1 >> 32); } }
        __syncthreads();
    }
    {
        const Src ss{P.KV6 + 2 * KV6_STRIDE + bg * SEQ * 64, 64, P.KV6 + 3 * KV6_STRIDE + bg * 64 * SEQ, SEQ};
        acc_reset(A);
        run_tiles<2>(lds, ss, 0, cur + 1, qr, A, tid, r32, hi, ql, cur, 0.f);
        const float lt = A.l + __shfl_xor(A.l, 32); const float sc = g1 / lt;
#pragma unroll
        for (int r = 0; r < 16; ++r) { out0[r] += sc * A.o0[r]; out1[r] += sc * A.o1[r]; }
    }
    {
        const Src sw{P.KV6 + 4 * KV6_STRIDE + bg * SEQ * 64, 64, P.KV6 + 5 * KV6_STRIDE + bg * 64 * SEQ, SEQ};
        acc_reset(A);
        run_tiles<3>(lds, sw, cur - 8 > 0 ? cur - 8 : 0, cur + 1, qr, A, tid, r32, hi, ql, cur, 0.f);
        const float lt = A.l + __shfl_xor(A.l, 32); const float sc = g2 / lt;
#pragma unroll
        for (int r = 0; r < 16; ++r) { out0[r] += sc * A.o0[r]; out1[r] += sc * A.o1[r]; }
    }
    store_out(P.OA + row * 1024 + (g * 4 + hh) * 64, out0, out1, hi);
}
__device__ __forceinline__ void mem_unit(const bf16_t* Qsrc, int qstride, const bf16_t* MKVp, const bf16_t* MVt, bf16_t* OAp, int b, int tb, int h, LAS unsigned char* lds, int tid) {
    asm volatile("" : "+v"(tid));
    const int lane = tid & 63, wave = __builtin_amdgcn_readfirstlane(tid >> 6), r32 = lane & 31, hi = lane >> 5;
    const size_t row = (size_t)b * SEQ + tb * 256 + 32 * wave + r32;
    bf16x8 qr[4]; load_q(qr, Qsrc + row * qstride + h * 64 + hi * 8);
    const Src sm{MKVp + (size_t)b * 256 * 512 + h * 64, 512, MVt + ((size_t)b * 256 + h * 64) * 256, 256};
    Acc A; acc_reset(A);
    run_tiles<4>(lds, sm, 0, 4, qr, A, tid, r32, hi, 0, 0, 0.f);
    const float lt = A.l + __shfl_xor(A.l, 32); const float sc = 1.0f / lt;
#pragma unroll
    for (int r = 0; r < 16; ++r) { A.o0[r] *= sc; A.o1[r] *= sc; }
    store_out(OAp + row * 1024 + 768 + h * 64, A.o0, A.o1, hi);
}
}

namespace rk {
constexpr int STR = 72, SLOT = 64 * STR * 2;
constexpr int OFF_DG = 15 * SLOT, OFF_GS = OFF_DG + 4 * 16 * 17 * 4, OFF_PC = OFF_GS + 8 * 64 * 4, OFF_BON = OFF_PC + 256;
static_assert(OFF_BON + 256 <= LDS_BYTES, "rk lds");
struct MM { f32x4 c[2]; };
__device__ __forceinline__ void mm_zero(MM& m) { m.c[0] = (f32x4){0.f, 0.f, 0.f, 0.f}; m.c[1] = (f32x4){0.f, 0.f, 0.f, 0.f}; }
__device__ __forceinline__ void mm_acc(MM& m, const LAS unsigned char* G, const LAS unsigned char* H, int wave, int lane) {
    const int l15 = lane & 15, q = lane >> 4, yt = wave & 3, xt0 = 2 * (wave >> 2);
    const LAS unsigned char* hp = H + (16 * yt + l15) * (STR * 2) + q * 16;
    const LAS unsigned char* gp = G + (16 * xt0 + l15) * (STR * 2) + q * 16;
#pragma unroll
    for (int ks = 0; ks < 2; ++ks) {
        const bf16x8 av = *(const LAS bf16x8*)(hp + ks * 64);
#pragma unroll
        for (int t = 0; t < 2; ++t) { const bf16x8 bv = *(const LAS bf16x8*)(gp + t * 16 * (STR * 2) + ks * 64);
            m.c[t] = __builtin_amdgcn_mfma_f32_16x16x32_bf16(av, bv, m.c[t], 0, 0, 0); }
    }
}
__device__ __forceinline__ void mm_acc_gl(MM& m, const LAS unsigned char* G, const bf16_t* Hg, int ldh, int wave, int lane) {
    const int l15 = lane & 15, q = lane >> 4, yt = wave & 3, xt0 = 2 * (wave >> 2);
    const bf16_t* hp = Hg + (size_t)(16 * yt + l15) * ldh + q * 8;
    const LAS unsigned char* gp = G + (16 * xt0 + l15) * (STR * 2) + q * 16;
#pragma unroll
    for (int ks = 0; ks < 2; ++ks) {
        const bf16x8 av = *(const bf16x8*)(hp + ks * 32);
#pragma unroll
        for (int t = 0; t < 2; ++t) { const bf16x8 bv = *(const LAS bf16x8*)(gp + t * 16 * (STR * 2) + ks * 64);
            m.c[t] = __builtin_amdgcn_mfma_f32_16x16x32_bf16(av, bv, m.c[t], 0, 0, 0); }
    }
}
template <class F> __device__ __forceinline__ void mm_out(const MM& m, int wave, int lane, F f) {
#pragma unroll
    for (int t = 0; t < 2; ++t) f(16 * (2 * (wave >> 2) + t) + (lane & 15), 16 * (wave & 3) + 4 * (lane >> 4), m.c[t]);
}
__device__ __forceinline__ void st_bf4(LAS unsigned char* arr, int x, int y0, const f32x4& v) { *(LAS u32x2*)(arr + x * (STR * 2) + y0 * 2) = (u32x2){pk2(v[0], v[1]), pk2(v[2], v[3])}; }
__device__ __forceinline__ f32x4 ld_bf4(const LAS unsigned char* arr, int x, int y0) { const u32x2 w = *(const LAS u32x2*)(arr + x * (STR * 2) + y0 * 2); return (f32x4){bf_lo(w.x), bf_hi(w.x), bf_lo(w.y), bf_hi(w.y)}; }

struct P { const bf16_t* PROJ; const float *mu, *w0, *a0, *k_k, *k_a, *r_k, *ln_g, *ln_b; const bf16_t *W2T, *A2T, *G2T; bf16_t *MS, *GS; bf16_t* OA; unsigned char* ws; };
__device__ __forceinline__ bf16_t* hs_ptr(unsigned char* ws, int u) { return (bf16_t*)(ws + (u < 8 ? (size_t)(88 + u) * MiB : (size_t)(240 + u - 8) * MiB)); }

template <int PH>
__device__ __forceinline__ void chunk_unit(const P& p, int u, int c, LAS unsigned char* lds, int tid) {
    asm volatile("" : "+v"(tid));
    const int lane = tid & 63, wave = __builtin_amdgcn_readfirstlane(tid >> 6);
    const int b = u / 12, h = u % 12, hc = h * 64;
#define SL(n) (lds + (n) * SLOT)
    LAS unsigned char *AT = SL(0), *BT = SL(1), *KT = SL(2), *RT = SL(3), *ATt = SL(4), *VTt = SL(5), *BTt = SL(6), *GTb = SL(6), *KTt = SL(7), *SG0 = SL(7);
    LAS unsigned char *AAK = SL(8), *ARB = SL(9), *ARK = SL(10), *AABt = SL(11), *Dm = SL(12), *Dt = SL(13), *Nm = SL(14), *TT = SL(14), *SG1 = SL(14);
    LAS unsigned char *Nt = SL(0), *N2 = SL(1), *N2t = SL(2), *X1t = SL(0), *Wt = SL(1), *U0t = SL(2), *QH = SL(11), *Ht = SL(12);
    LAS unsigned char *TW = SL(12), *AL = SL(13);
    LAS float* WD = (LAS float*)SL(8); LAS float* AD = (LAS float*)(SL(8) + 17408);
    LAS float* Yf = (LAS float*)SL(13);
    LAS float* DG = (LAS float*)(lds + OFF_DG);
    LAS float* GSm = (LAS float*)(lds + OFF_GS);
    LAS float* PCv = (LAS float*)(lds + OFF_PC); LAS float* BON = (LAS float*)(lds + OFF_BON);
    const int tl0 = 8 * wave;
    const size_t grow0 = (size_t)b * SEQ + c * 64 + tl0;
    const bool hasprev = (c * 64 + tl0) > 0;
    float xr[8], xk[8], xv[8];
    {
        auto ldcol = [&](int col, float (&xs)[8]) {
            const bf16_t* pp = p.PROJ + grow0 * RWKV_N + col; const float m = p.mu[col];
            float prev = hasprev ? bf2f(*(pp - RWKV_N)) : 0.f;
#pragma unroll
            for (int tt = 0; tt < 8; ++tt) { const float cur = bf2f(pp[(size_t)tt * RWKV_N]); xs[tt] = cur + (prev - cur) * m; prev = cur; }
        };
        ldcol(hc + lane, xr); ldcol(768 + hc + lane, xk); ldcol(1536 + hc + lane, xv);
        float xs[8];
        ldcol(2304 + lane, xs);
#pragma unroll
        for (int tt = 0; tt < 8; ++tt) *(LAS bf16_t*)(TW + (tl0 + tt) * (STR * 2) + lane * 2) = (bf16_t)f2bf(tanhf(xs[tt]));
        ldcol(2368 + lane, xs);
#pragma unroll
        for (int tt = 0; tt < 8; ++tt) *(LAS bf16_t*)(AL + (tl0 + tt) * (STR * 2) + lane * 2) = (bf16_t)f2bf(xs[tt]);
        if (PH == 1) {
            ldcol(2432 + lane, xs);
#pragma unroll
            for (int tt = 0; tt < 8; ++tt) *(LAS bf16_t*)(SG0 + (tl0 + tt) * (STR * 2) + lane * 2) = (bf16_t)f2bf(sigmoidf_(xs[tt]));
            ldcol(2496 + lane, xs);
#pragma unroll
            for (int tt = 0; tt < 8; ++tt) *(LAS bf16_t*)(SG1 + (tl0 + tt) * (STR * 2) + lane * 2) = (bf16_t)f2bf(sigmoidf_(xs[tt]));
        }
    }
    __syncthreads();
    {
        MM m; mm_zero(m); mm_acc_gl(m, TW, p.W2T + (size_t)hc * 64, 64, wave, lane);
        mm_out(m, wave, lane, [&](int x, int y0, const f32x4& v) { *(LAS f32x4*)(WD + x * 68 + y0) = v; });
        mm_zero(m); mm_acc_gl(m, AL, p.A2T + (size_t)hc * 64, 64, wave, lane);
        mm_out(m, wave, lane, [&](int x, int y0, const f32x4& v) { *(LAS f32x4*)(AD + x * 68 + y0) = v; });
    }
    MM mg; mm_zero(mg);
    if (PH == 1) { mm_acc_gl(mg, SG0, p.G2T + (size_t)hc * 128, 128, wave, lane); mm_acc_gl(mg, SG1, p.G2T + (size_t)hc * 128 + 64, 128, wave, lane); }
    __syncthreads();
    if (PH == 1) { mm_out(mg, wave, lane, [&](int x, int y0, const f32x4& v) { st_bf4(GTb, x, y0, v); }); }
    {
        const int j = lane; const float w0 = p.w0[hc + j], a0 = p.a0[hc + j], kkc = p.k_k[hc + j], kac = p.k_a[hc + j];
        float ldv[8], alr[8], kk[8], kp[8];
        float cs = 0.f;
#pragma unroll
        for (int tt = 0; tt < 8; ++tt) { const int t = tl0 + tt;
            const float wd = w0 + WD[t * 68 + j]; const float sp = __logf(1.0f + __expf(-wd)); const float w = -sp - 0.5f;
            const float l = -__expf(w); cs += l; ldv[tt] = cs;
            const float a = sigmoidf_(a0 + AD[t * 68 + j]); alr[tt] = a;
            const float kr = xk[tt] * kkc; const float ss = wave_sum(kr * kr); kk[tt] = kr * rsqrtf(fmaxf(ss, 1e-24f));
            kp[tt] = xk[tt] * (1.0f + (a - 1.0f) * kac);
            if (PH == 1) { const float bs = wave_sum(xr[tt] * kp[tt] * p.r_k[hc + j]); if (lane == 0) BON[t] = bs; }
        }
        GSm[wave * 64 + j] = cs;
        __syncthreads();
        float pre = 0.f, tot = 0.f;
#pragma unroll
        for (int w2 = 0; w2 < 8; ++w2) { const float g = GSm[w2 * 64 + j]; tot += g; if (w2 < wave) pre += g; }
        const float pc = __expf(tot);
        if (wave == 0) PCv[j] = pc;
        u32x4 wa, wb, wk, wv;
        float ea[8], eb[8], ek[8];
#pragma unroll
        for (int tt = 0; tt < 8; ++tt) { const int t = tl0 + tt;
            const float lp = pre + ldv[tt]; const float lprev = lp - (ldv[tt] - (tt ? ldv[tt - 1] : 0.f));
            const float einv = __expf(-lp);
            const float at = -kk[tt] * __expf(lprev), bt = kk[tt] * alr[tt] * einv, kt = kp[tt] * einv;
            ea[tt] = at; eb[tt] = bt; ek[tt] = kt;
            *(LAS bf16_t*)(AT + t * (STR * 2) + j * 2) = (bf16_t)f2bf(at);
            *(LAS bf16_t*)(BT + t * (STR * 2) + j * 2) = (bf16_t)f2bf(bt);
            *(LAS bf16_t*)(KT + t * (STR * 2) + j * 2) = (bf16_t)f2bf(kt);
            if (PH == 1) *(LAS bf16_t*)(RT + t * (STR * 2) + j * 2) = (bf16_t)f2bf(xr[tt] * __expf(lp));
        }
        wa = (u32x4){pk2(ea[0], ea[1]), pk2(ea[2], ea[3]), pk2(ea[4], ea[5]), pk2(ea[6], ea[7])};
        wv = (u32x4){pk2(xv[0], xv[1]), pk2(xv[2], xv[3]), pk2(xv[4], xv[5]), pk2(xv[6], xv[7])};
        *(LAS u32x4*)(ATt + j * (STR * 2) + tl0 * 2) = wa;
        *(LAS u32x4*)(VTt + j * (STR * 2) + tl0 * 2) = wv;
        if (PH == 0) {
            wb = (u32x4){pk2(eb[0], eb[1]), pk2(eb[2], eb[3]), pk2(eb[4], eb[5]), pk2(eb[6], eb[7])};
            wk = (u32x4){pk2(ek[0], ek[1]), pk2(ek[2], ek[3]), pk2(ek[4], ek[5]), pk2(ek[6], ek[7])};
            *(LAS u32x4*)(BTt + j * (STR * 2) + tl0 * 2) = wb;
            *(LAS u32x4*)(KTt + j * (STR * 2) + tl0 * 2) = wk;
        }
    }
    __syncthreads();
    {
        { LAS u32x4* z = (LAS u32x4*)Dm; for (int i = tid; i < 2 * SLOT / 16; i += NTHREADS) z[i] = (u32x4){0u, 0u, 0u, 0u}; }
        MM m; mm_zero(m); mm_acc(m, AT, BT, wave, lane);
        mm_out(m, wave, lane, [&](int x, int y0, const f32x4& v) { if ((x >> 4) == (y0 >> 4)) {
#pragma unroll
            for (int e = 0; e < 4; ++e) DG[(x >> 4) * 272 + (x & 15) * 17 + (y0 & 15) + e] = (y0 + e < x) ? v[e] : 0.f; } });
        mm_zero(m); mm_acc(m, BT, AT, wave, lane);
        mm_out(m, wave, lane, [&](int x, int y0, const f32x4& v) { const f32x4 o = ((y0 >> 4) > (x >> 4)) ? v : (f32x4){0.f, 0.f, 0.f, 0.f}; st_bf4(AABt, x, y0, o); });
        mm_zero(m); mm_acc(m, AT, KT, wave, lane);
        mm_out(m, wave, lane, [&](int x, int y0, const f32x4& v) { f32x4 o;
#pragma unroll
            for (int e = 0; e < 4; ++e) o[e] = (y0 + e < x) ? v[e] : 0.f;
            st_bf4(AAK, x, y0, o); });
        if (PH == 1) {
            mm_zero(m); mm_acc(m, RT, BT, wave, lane);
            mm_out(m, wave, lane, [&](int x, int y0, const f32x4& v) { f32x4 o;
#pragma unroll
                for (int e = 0; e < 4; ++e) o[e] = (y0 + e <= x) ? v[e] : 0.f;
                st_bf4(ARB, x, y0, o); });
            mm_zero(m); mm_acc(m, RT, KT, wave, lane);
            mm_out(m, wave, lane, [&](int x, int y0, const f32x4& v) { f32x4 o;
#pragma unroll
                for (int e = 0; e < 4; ++e) o[e] = (y0 + e <= x) ? v[e] : 0.f;
                st_bf4(ARK, x, y0, o); });
        }
    }
    __syncthreads();
    if (wave < 4 && lane < 16) {
        const LAS float* Ab = DG + wave * 272; float Tr[16];
#pragma unroll
        for (int t = 0; t < 16; ++t) { float acc = (t == lane) ? 1.f : 0.f;
#pragma unroll
            for (int s = 0; s < t; ++s) acc += Ab[t * 17 + s] * Tr[s];
            Tr[t] = acc; }
        const int r0 = 16 * wave;
#pragma unroll
        for (int t = 0; t < 16; ++t) *(LAS bf16_t*)(Dm + (r0 + t) * (STR * 2) + (r0 + lane) * 2) = (bf16_t)f2bf(Tr[t]);
        *(LAS u32x4*)(Dt + (r0 + lane) * (STR * 2) + r0 * 2) = (u32x4){pk2(Tr[0], Tr[1]), pk2(Tr[2], Tr[3]), pk2(Tr[4], Tr[5]), pk2(Tr[6], Tr[7])};
        *(LAS u32x4*)(Dt + (r0 + lane) * (STR * 2) + r0 * 2 + 16) = (u32x4){pk2(Tr[8], Tr[9]), pk2(Tr[10], Tr[11]), pk2(Tr[12], Tr[13]), pk2(Tr[14], Tr[15])};
    }
    __syncthreads();
    {
        MM m; mm_zero(m); mm_acc(m, Dm, AABt, wave, lane); mm_out(m, wave, lane, [&](int x, int y0, const f32x4& v) { st_bf4(Nm, x, y0, v); });
        mm_zero(m); mm_acc(m, AABt, Dm, wave, lane); mm_out(m, wave, lane, [&](int x, int y0, const f32x4& v) { st_bf4(Nt, x, y0, v); });
    }
    __syncthreads();
    {
        MM m; mm_zero(m); mm_acc(m, Nm, Nt, wave, lane); mm_out(m, wave, lane, [&](int x, int y0, const f32x4& v) { st_bf4(N2, x, y0, v); });
        mm_zero(m); mm_acc(m, Nt, Nm, wave, lane); mm_out(m, wave, lane, [&](int x, int y0, const f32x4& v) { st_bf4(N2t, x, y0, v); });
    }
    __syncthreads();
    {
        MM m; mm_zero(m); mm_acc(m, Nm, N2t, wave, lane);
        mm_out(m, wave, lane, [&](int x, int y0, const f32x4& v) { f32x4 o = v + ld_bf4(Nm, x, y0) + ld_bf4(N2, x, y0);
#pragma unroll
            for (int e = 0; e < 4; ++e) if (y0 + e == x) o[e] += 1.0f;
            st_bf4(N2, x, y0, o); });
    }
    __syncthreads();
    {
        MM m; mm_zero(m); mm_acc(m, N2, Dt, wave, lane); mm_out(m, wave, lane, [&](int x, int y0, const f32x4& v) { st_bf4(TT, x, y0, v); });
    }
    __syncthreads();
    {
        MM m; mm_zero(m); mm_acc(m, VTt, AAK, wave, lane); mm_out(m, wave, lane, [&](int x, int y0, const f32x4& v) { st_bf4(X1t, x, y0, v); });
        mm_zero(m); mm_acc(m, ATt, TT, wave, lane); mm_out(m, wave, lane, [&](int x, int y0, const f32x4& v) { st_bf4(Wt, x, y0, v); });
        if (PH == 1) {
            const bf16_t* hp = hs_ptr(p.ws, u) + (size_t)c * 4096; const int row = tid >> 3, ch = tid & 7;
            *(LAS u32x4*)(Ht + row * (STR * 2) + ch * 16) = *(const u32x4*)(hp + row * 64 + ch * 8);
        }
    }
    __syncthreads();
    { MM m; mm_zero(m); mm_acc(m, X1t, TT, wave, lane); mm_out(m, wave, lane, [&](int x, int y0, const f32x4& v) { st_bf4(U0t, x, y0, v); }); }
    __syncthreads();
    if (PH == 0) {
        bf16_t* Mo = p.MS + ((size_t)u * 128 + c) * 4096; bf16_t* Go = p.GS + ((size_t)u * 128 + c) * 4096;
        MM m; mm_zero(m); mm_acc(m, BTt, Wt, wave, lane);
        mm_out(m, wave, lane, [&](int x, int y0, const f32x4& v) { const float pc = PCv[x]; f32x4 o = v;
#pragma unroll
            for (int e = 0; e < 4; ++e) { if (y0 + e == x) o[e] += 1.0f; o[e] *= pc; }
            *(u32x2*)(Mo + x * 64 + y0) = (u32x2){pk2(o[0], o[1]), pk2(o[2], o[3])}; });
        mm_zero(m); mm_acc(m, U0t, BTt, wave, lane); mm_acc(m, VTt, KTt, wave, lane);
        mm_out(m, wave, lane, [&](int x, int y0, const f32x4& v) { const f32x4 pc = *(const LAS f32x4*)(PCv + y0); const f32x4 o = v * pc;
            *(u32x2*)(Go + x * 64 + y0) = (u32x2){pk2(o[0], o[1]), pk2(o[2], o[3])}; });
    } else {
        { MM m; mm_zero(m); mm_acc(m, ARB, Wt, wave, lane); mm_out(m, wave, lane, [&](int x, int y0, const f32x4& v) { const f32x4 o = v + ld_bf4(RT, x, y0); st_bf4(QH, x, y0, o); }); }
        __syncthreads();
        { MM m; mm_zero(m); mm_acc(m, QH, Ht, wave, lane); mm_acc(m, ARB, U0t, wave, lane); mm_acc(m, ARK, VTt, wave, lane);
          __syncthreads();
          mm_out(m, wave, lane, [&](int x, int y0, const f32x4& v) { *(LAS f32x4*)(Yf + x * 68 + y0) = v; }); }
        __syncthreads();
        { const int i = lane; const float lg = p.ln_g[hc + i], lb = p.ln_b[hc + i];
#pragma unroll
          for (int tt = 0; tt < 8; ++tt) { const int t = tl0 + tt;
              const float y = Yf[t * 68 + i]; const float mean = wave_sum(y) * (1.f / 64.f); const float d = y - mean; const float var = wave_sum(d * d) * (1.f / 64.f);
              const float yn = d * rsqrtf(var + 64e-5f) * lg + lb;
              const float g = bf2f(*(const LAS bf16_t*)(GTb + t * (STR * 2) + i * 2));
              const float o = (yn + BON[t] * xv[tt]) * g;
              p.OA[(grow0 + tt) * 1024 + hc + i] = (bf16_t)f2bf(o); } }
    }
    __syncthreads();
#undef SL
}

__device__ __forceinline__ void scan_unit(const P& p, int u, int tid) {
    asm volatile("" : "+v"(tid));
    const int lane = tid & 63, v = tid >> 6, l15 = lane & 15, q = lane >> 4, i = 16 * v + l15;
    if (v >= 4) return;
    const bf16_t* Mp = p.MS + (size_t)u * 128 * 4096; const bf16_t* Gp = p.GS + (size_t)u * 128 * 4096; bf16_t* Hp = hs_ptr(p.ws, u);
    f32x4 Hacc[4];
#pragma unroll
    for (int jt = 0; jt < 4; ++jt) Hacc[jt] = (f32x4){0.f, 0.f, 0.f, 0.f};
    u32x2 mA[4][2][2], gC[4];
#define RK_LOADMG(cc) do { const bf16_t* mp_ = Mp + (size_t)(cc) * 4096; const bf16_t* gp_ = Gp + (size_t)(cc) * 4096; \
        _Pragma("unroll") for (int jt = 0; jt < 4; ++jt) { _Pragma("unroll") for (int ks = 0; ks < 2; ++ks) { \
            mA[jt][ks][0] = *(const u32x2*)(mp_ + (16 * jt + l15) * 64 + 32 * ks + 4 * q); mA[jt][ks][1] = *(const u32x2*)(mp_ + (16 * jt + l15) * 64 + 32 * ks + 16 + 4 * q); } \
            gC[jt] = *(const u32x2*)(gp_ + i * 64 + 16 * jt + 4 * q); } } while (0)
    RK_LOADMG(0);
    for (int c = 0; c < 128; ++c) {
#pragma unroll
        for (int jt = 0; jt < 4; ++jt) *(u32x2*)(Hp + (size_t)c * 4096 + i * 64 + 16 * jt + 4 * q) = (u32x2){pk2(Hacc[jt][0], Hacc[jt][1]), pk2(Hacc[jt][2], Hacc[jt][3])};
        if (c == 127) break;
        bf16x8 bfr[2];
#pragma unroll
        for (int ks = 0; ks < 2; ++ks) bfr[ks] = __builtin_bit_cast(bf16x8, (u32x4){pk2(Hacc[2 * ks][0], Hacc[2 * ks][1]), pk2(Hacc[2 * ks][2], Hacc[2 * ks][3]), pk2(Hacc[2 * ks + 1][0], Hacc[2 * ks + 1][1]), pk2(Hacc[2 * ks + 1][2], Hacc[2 * ks + 1][3])});
        bf16x8 afr[4][2];
#pragma unroll
        for (int jt = 0; jt < 4; ++jt) {
#pragma unroll
            for (int ks = 0; ks < 2; ++ks) afr[jt][ks] = __builtin_bit_cast(bf16x8, (u32x4){mA[jt][ks][0].x, mA[jt][ks][0].y, mA[jt][ks][1].x, mA[jt][ks][1].y});
            Hacc[jt] = (f32x4){bf_lo(gC[jt].x), bf_hi(gC[jt].x), bf_lo(gC[jt].y), bf_hi(gC[jt].y)}; }
        if (c + 1 < 127) RK_LOADMG(c + 1);
#pragma unroll
        for (int jt = 0; jt < 4; ++jt)
#pragma unroll
            for (int ks = 0; ks < 2; ++ks) Hacc[jt] = __builtin_amdgcn_mfma_f32_16x16x32_bf16(afr[jt][ks], bfr[ks], Hacc[jt], 0, 0, 0);
    }
#undef RK_LOADMG
}
}

__global__ void __launch_bounds__(NTHREADS, 2) fwd_kernel(Args a) {
    extern __shared__ __attribute__((aligned(16))) unsigned char lds_raw[];
    LAS unsigned char* lds = (LAS unsigned char*)lds_raw;
    cg::grid_group grid = cg::this_grid();
    const int G = gridDim.x, bid = blockIdx.x, NGW = G * NWAVES, NGT = G * NTHREADS;
#define TID ({ int t_ = threadIdx.x; asm volatile("" : "+v"(t_)); t_; })
#define tid TID
#define lane (TID & 63)
#define wave (__builtin_amdgcn_readfirstlane(TID >> 6))
#define gw (bid * NWAVES + wave)
#define gtid (bid * NTHREADS + TID)
#define IN(i) (a.in[i])
#define WSP(T, off) ((T*)(a.ws + (off)))
#define XIN IN(0)
#define MEMIN IN(1)
#define positions ((const int*)IN(2))
#define mem_norm_g IN(3)
#define w_mem_kv IN(4)
#define pre_mix_g IN(5)
#define post_mix_g IN(6)
#define pre_ffn_g IN(7)
#define post_ffn_g IN(8)
#define w_out IN(9)
#define w_ffn_in IN(10)
#define w_ffn_out IN(11)
#define nsa_w_in IN(12)
#define nsa_gate_b IN(13)
#define cmp_pos_k IN(14)
#define cmp_pos_v IN(15)
#define cmp_k_w1 IN(16)
#define cmp_k_w2 IN(17)
#define cmp_v_w1 IN(18)
#define cmp_v_w2 IN(19)
#define rwkv_w_in IN(20)
#define OUTP (a.out)
#define WT_NSA WSP(bf16_t, WS_WT_NSA)
#define WT_RWKV WSP(bf16_t, WS_WT_RWKV)
#define WT_OUT WSP(bf16_t, WS_WT_OUT)
#define WT_FIN WSP(bf16_t, WS_WT_FIN)
#define WT_FOUT WSP(bf16_t, WS_WT_FOUT)
#define WT_C1K WSP(bf16_t, WS_WT_C1K)
#define WT_C1V WSP(bf16_t, WS_WT_C1V)
#define WT_MKV WSP(bf16_t, WS_WT_MKV)
#define MEMN WSP(bf16_t, WS_MEMN)
#define MKV WSP(bf16_t, WS_MKV)
#define COS WSP(float, WS_COS)
#define SIN WSP(float, WS_SIN)
#define KC WSP(bf16_t, WS_KC)
#define VC WSP(bf16_t, WS_VC)
#define BIASK WSP(float, WS_BIASK)
#define BIASV WSP(float, WS_BIASV)
#define GATES WSP(float, WS_GATES)
#define CMPHK WSP(bf16_t, WS_CMPHK)
#define CMPHV WSP(bf16_t, WS_CMPHV)
#define HN_A WSP(bf16_t, WS_HN_A)
#define HN_B WSP(bf16_t, WS_HN_B)
#define OA WSP(bf16_t, WS_OA)
#define FF WSP(float, WS_FF)
#define Qb WSP(bf16_t, WS_Q)
#define KV6 WSP(bf16_t, WS_KV6)
#define QM WSP(bf16_t, WS_QM)
#define ACT WSP(bf16_t, WS_ACT)
#define PROJ1 WSP(bf16_t, WS_PROJ1)
#define MVT WSP(bf16_t, WS_MVT)
#define W2T WSP(bf16_t, WS_W2T)
#define A2T WSP(bf16_t, WS_A2T)
#define G2T WSP(bf16_t, WS_G2T)
#define RKM WSP(bf16_t, WS_RKM)
#define RKG WSP(bf16_t, WS_RKG)

    {
        LAS float* scr = (LAS float*)(lds + wave * 16384);
        const int I_NSA = (DM / 64) * ((NSA_N + 31) / 32), I_RWKV = (DM / 64) * (RWKV_N / 32), I_OUT = (DM / 64) * (DM / 32), I_FIN = (DM / 64) * (FFN_N2 / 32), I_FOUT = (FFN_H / 64) * (DM / 32);
        const int I_C1 = (2048 / 64) * (256 / 32), I_MKV = (DM / 64) * (512 / 32);
        const int NIT = I_NSA + I_RWKV + 2 * I_OUT + 2 * I_FIN + 2 * I_FOUT + 2 * I_C1 + I_MKV + 24 + 24 + 48;
        for (int it = gw; it < NIT; it += NGW) {
            int r = it;
            if (r < I_NSA) { transpose_item(nsa_w_in, DM, NSA_N, WT_NSA, MapNsa(), scr, r, lane); continue; } r -= I_NSA;
            if (r < I_RWKV) { transpose_item(rwkv_w_in, DM, RWKV_N, WT_RWKV, MapId(), scr, r, lane); continue; } r -= I_RWKV;
            if (r < 2 * I_OUT) { const int l = r / I_OUT; transpose_item(w_out + (size_t)l * DM * DM, DM, DM, WT_OUT + (size_t)l * DM * DM, MapId(), scr, r % I_OUT, lane); continue; } r -= 2 * I_OUT;
            if (r < 2 * I_FIN) { const int l = r / I_FIN; transpose_item(w_ffn_in + (size_t)l * DM * FFN_N2, DM, FFN_N2, WT_FIN + (size_t)l * DM * FFN_N2, MapFfn(), scr, r % I_FIN, lane); continue; } r -= 2 * I_FIN;
            if (r < 2 * I_FOUT) { const int l = r / I_FOUT; transpose_item(w_ffn_out + (size_t)l * FFN_H * DM, FFN_H, DM, WT_FOUT + (size_t)l * FFN_H * DM, MapId(), scr, r % I_FOUT, lane); continue; } r -= 2 * I_FOUT;
            if (r < I_C1) { transpose_item(cmp_k_w1, 2048, 256, WT_C1K, MapId(), scr, r, lane); continue; } r -= I_C1;
            if (r < I_C1) { transpose_item(cmp_v_w1, 2048, 256, WT_C1V, MapId(), scr, r, lane); continue; } r -= I_C1;
            if (r < I_MKV) { transpose_item(w_mem_kv, DM, 512, WT_MKV, MapId(), scr, r, lane); continue; } r -= I_MKV;
            if (r < 24) { transpose_item(a.in[23], 64, PRIM, W2T, MapId(), scr, r, lane); continue; } r -= 24;
            if (r < 24) { transpose_item(a.in[25], 64, PRIM, A2T, MapId(), scr, r, lane); continue; } r -= 24;
            transpose_item(a.in[26], 128, PRIM, G2T, MapId(), scr, r, lane);
        }
        if (gtid == 0) *(unsigned*)a.ws = 0u;
        for (int i = gtid; i < (NSA_NP - NSA_N) * DM / 8; i += NGT) ((u32x4*)(WT_NSA + (size_t)NSA_N * DM))[i] = (u32x4){0u, 0u, 0u, 0u};
        for (int i = gtid; i < MTOK * 8; i += NGT) { const int row = i >> 3, k = i & 7;
            const float inv = (k == 0) ? 1.0f : (k == 1) ? 0.1939227432012558f : (k == 2) ? 0.03760603070259094f : (k == 3) ? 0.007292664609849453f : (k == 4) ? 0.0014142135623842478f : (k == 5) ? 0.00027424818836152554f : (k == 6) ? 5.318296098266728e-05f : 1.0313386155758053e-05f;
            const float ang = (float)positions[row] * inv; COS[i] = cosf(ang); SIN[i] = sinf(ang); }
        if (gtid < 512) { const int hh = gtid & 255; const float* pos = gtid < 256 ? cmp_pos_k : cmp_pos_v; const float* w1 = gtid < 256 ? cmp_k_w1 : cmp_v_w1; float s = 0.f;
            for (int k = 0; k < 2048; ++k) s += pos[k] * w1[(size_t)k * 256 + hh];
            (gtid < 256 ? BIASK : BIASV)[hh] = s; }
        for (int m = gw; m < MTOK; m += NGW) rms_row_to_bf16(XIN + (size_t)m * DM, pre_mix_g, HN_A + (size_t)m * DM, lane);
        for (int m = gw; m < BATCH * NMEM; m += NGW) rms_row_to_bf16(MEMIN + (size_t)m * DM, mem_norm_g, MEMN + (size_t)m * DM, lane);
    }
    grid.sync();

    {
        { pg8::Gemm g{MEMN, WT_MKV, BATCH * NMEM, 512, DM, DM}; pg8::StaticOrder S; S.init(g.M, g.N, G, bid); pg8::EpiBf16 E{MKV, 512};
          pg8::gemm_phase<pg8::EpiBf16, true>(lds, g, S, E); }
        { pg8::Gemm g{HN_A, WT_NSA, MTOK, NSA_NP, DM, DM}; pg8::StaticOrder S; S.init(g.M, g.N, G, bid); pg8::EpiNsaSplit E{Qb, KV6, QM, GATES, nsa_gate_b};
          pg8::gemm_phase<pg8::EpiNsaSplit, true>(lds, g, S, E); }
    }
    grid.sync();

    {
        { pg8::Gemm g{KV6, WT_C1K, 3072, 256, 2048, 1024}; pg8::StaticOrder S; S.init(g.M, g.N, G, bid); pg8::EpiGeluBias E{CMPHK, 256, BIASK};
          pg8::gemm_phase<pg8::EpiGeluBias, true>(lds, g, S, E); }
        { pg8::Gemm g{KV6 + KV6_STRIDE, WT_C1V, 3072, 256, 2048, 1024}; pg8::StaticOrder S; S.init(g.M, g.N, G, bid); pg8::EpiGeluBias E{CMPHV, 256, BIASV};
          pg8::gemm_phase<pg8::EpiGeluBias, true>(lds, g, S, E); }
        for (int i = gtid; i < BATCH * 256 * 256; i += NGT) { const int m = i & 255, c = (i >> 8) & 255, b = i >> 16; MVT[i] = MKV[((size_t)b * 256 + m) * 512 + 256 + c]; }
        for (int i = gtid; i < MTOK * 18 * 8; i += NGT) { const int k = i & 7, slot = (i >> 3) % 18, row = i / 144;
            bf16_t* p;
            if (slot < 12) p = Qb + (size_t)row * 768 + slot * 64;
            else { const int s2 = slot - 12, which = s2 / 3, gg = s2 % 3, b = row >> 13, s = row & 8191; p = KV6 + (size_t)(which == 0 ? 2 : 4) * KV6_STRIDE + ((size_t)(b * 3 + gg) * SEQ + s) * HD; }
            const float c = COS[row * 8 + k], sn = SIN[row * 8 + k]; const float t1 = bf2f(p[k]), t2 = bf2f(p[8 + k]);
            p[k] = (bf16_t)f2bf(t1 * c - t2 * sn); p[8 + k] = (bf16_t)f2bf(t1 * sn + t2 * c); }
    }
    grid.sync();

    {
        for (int it = gw; it < 2 * 3072; it += NGW) { const int kv = it / 3072, m = it % 3072, n = m & 511, bgi = m >> 9, b = bgi / 3;
            const bf16_t* hrow = (kv ? CMPHV : CMPHK) + (size_t)m * 256; const float* w2 = kv ? cmp_v_w2 : cmp_k_w2;
            float s = 0.f;
            for (int hh = 0; hh < 256; ++hh) s += bf2f(hrow[hh]) * w2[hh * 64 + lane];
            if (kv == 0) { const float other = __shfl(s, lane ^ 8);
                if (lane < 16 && n < 511) { const int prow = b * SEQ + 16 * n + 31; const float c = COS[prow * 8 + (lane & 7)], sn = SIN[prow * 8 + (lane & 7)];
                    s = (lane < 8) ? (s * c - other * sn) : (other * sn + s * c); } }
            if (n >= 511) s = 0.f;
            if (kv) VC[((size_t)bgi * 64 + lane) * 512 + n] = (bf16_t)f2bf(s); else KC[(size_t)m * 64 + lane] = (bf16_t)f2bf(s); }
    }
    grid.sync();

    {
        att::NsaP P{Qb, KV6, KC, VC, GATES, OA};
        LAS int* misc = (LAS int*)(lds + att::LDS_MISC);
        for (;;) {
            if (tid == 0) misc[0] = (int)atomicAdd((unsigned*)a.ws, 1u);
            __syncthreads();
            const int u = __builtin_amdgcn_readfirstlane(misc[0]);
            __syncthreads();
            if (u >= 1024) break;
            if (u < 768) { const int blk = 127 - u / 6, bgi = u % 6; att::nsa_unit(P, bgi / 3, bgi % 3, blk, lds, tid); }
            else { const int v = u - 768; att::mem_unit(QM, 256, MKV, MVT, OA, v >> 7, (v >> 2) & 31, v & 3, lds, tid); }
        }
    }
    grid.sync();

#pragma unroll
    for (int layer = 0; layer < 2; ++layer) {
        if (layer == 1) {
            { pg8::Gemm g{HN_B, WT_RWKV, MTOK, RWKV_N, DM, DM}; pg8::StaticOrder S; S.init(g.M, g.N, G, bid); pg8::EpiBf16 E{PROJ1, RWKV_N};
              pg8::gemm_phase<pg8::EpiBf16, true>(lds, g, S, E); }
            grid.sync();
            {
                for (int v = bid; v < 256; v += G) att::mem_unit(PROJ1 + 2560, RWKV_N, MKV, MVT, OA, v >> 7, (v >> 2) & 31, v & 3, lds, tid);
                __syncthreads();
                const rk::P RP{PROJ1, a.in[21], a.in[22], a.in[24], a.in[27], a.in[28], a.in[29], a.in[30], a.in[31], W2T, A2T, G2T, RKM, RKG, OA, a.ws};
                for (int it = bid; it < 24 * 128; it += G) rk::chunk_unit<0>(RP, it >> 7, it & 127, lds, tid);
            }
            grid.sync();
            {
                const rk::P RP{PROJ1, a.in[21], a.in[22], a.in[24], a.in[27], a.in[28], a.in[29], a.in[30], a.in[31], W2T, A2T, G2T, RKM, RKG, OA, a.ws};
                if (bid < 24) rk::scan_unit(RP, bid, tid);
            }
            grid.sync();
            {
                const rk::P RP{PROJ1, a.in[21], a.in[22], a.in[24], a.in[27], a.in[28], a.in[29], a.in[30], a.in[31], W2T, A2T, G2T, RKM, RKG, OA, a.ws};
                for (int it = bid; it < 24 * 128; it += G) rk::chunk_unit<1>(RP, it >> 7, it & 127, lds, tid);
            }
            grid.sync();
        }
        float* MIX = (float*)(a.ws + (layer == 0 ? WS_MIX0 : WS_MIX1));
        { pg8::Gemm g{OA, WT_OUT + (size_t)layer * DM * DM, MTOK, DM, DM, DM}; pg8::StaticOrder S; S.init(g.M, g.N, G, bid); pg8::EpiF32 E{MIX, DM};
          pg8::gemm_phase<pg8::EpiF32, true>(lds, g, S, E); }
        grid.sync();
        for (int m = gw; m < MTOK; m += NGW) res_row((layer == 0 ? XIN : OUTP) + (size_t)m * DM, MIX + (size_t)m * DM, post_mix_g + layer * DM, pre_ffn_g + layer * DM, OUTP + (size_t)m * DM, HN_A + (size_t)m * DM, lane);
        grid.sync();
        { pg8::Gemm g{HN_A, WT_FIN + (size_t)layer * DM * FFN_N2, MTOK, FFN_N2, DM, DM}; pg8::StaticOrder S; S.init(g.M, g.N, G, bid); pg8::EpiSwiglu E{ACT, FFN_H};
          pg8::gemm_phase<pg8::EpiSwiglu, true>(lds, g, S, E); }
        grid.sync();
        { pg8::Gemm g{ACT, WT_FOUT + (size_t)layer * FFN_H * DM, MTOK, DM, FFN_H, FFN_H}; pg8::StaticOrder S; S.init(g.M, g.N, G, bid); pg8::EpiF32 E{FF, DM};
          pg8::gemm_phase<pg8::EpiF32, true>(lds, g, S, E); }
        grid.sync();
        for (int m = gw; m < MTOK; m += NGW) res_row(OUTP + (size_t)m * DM, FF + (size_t)m * DM, post_ffn_g + layer * DM, layer == 0 ? pre_mix_g + DM : nullptr, OUTP + (size_t)m * DM, layer == 0 ? HN_B + (size_t)m * DM : nullptr, lane);
        if (layer == 0) grid.sync();
    }
}

#undef tid
#undef lane
#undef wave
#undef gw
#undef gtid
extern "C" void kernel_launch(void* const* d_in, const int* in_sizes, int n_in, void* d_out, int out_size, void* d_ws, size_t ws_size, hipStream_t stream) {
    static int grid = 0;
    if (grid == 0) {
        int dev = 0, cus = 0, per_cu = 0;
        hipGetDevice(&dev);
        hipDeviceGetAttribute(&cus, hipDeviceAttributeMultiprocessorCount, dev);
        hipFuncSetAttribute((const void*)fwd_kernel, hipFuncAttributeMaxDynamicSharedMemorySize, LDS_BYTES);
        hipOccupancyMaxActiveBlocksPerMultiprocessor(&per_cu, (const void*)fwd_kernel, NTHREADS, LDS_BYTES);
        if (per_cu < 1) { fprintf(stderr, "kernel_launch: occupancy query says %d blocks per CU\n", per_cu); per_cu = 1; }
        (void)hipGetLastError();
        grid = cus;
        if (n_in != 32) fprintf(stderr, "kernel_launch: expected 32 inputs, got %d\n", n_in);
    }
    Args a{};
    for (int i = 0; i < 32; ++i) a.in[i] = (const float*)d_in[i];
    a.out = (float*)d_out; a.ws = (unsigned char*)d_ws;
    void* args[] = {&a};
    hipError_t e = hipLaunchCooperativeKernel((const void*)fwd_kernel, dim3(grid), dim3(NTHREADS), args, LDS_BYTES, stream);
    if (e != hipSuccess) fprintf(stderr, "cooperative launch failed: %s (grid %d)\n", hipGetErrorString(e), grid);
}
```

```cpp
#include <hip/hip_runtime.h>
#include <hip/hip_cooperative_groups.h>
#include <cstdio>
#include <cstdint>
namespace cg = cooperative_groups;

#define LAS __attribute__((address_space(3)))
typedef unsigned short bf16_t;
typedef short bf16x8 __attribute__((ext_vector_type(8)));
typedef float f32x4 __attribute__((ext_vector_type(4)));
typedef float f32x2 __attribute__((ext_vector_type(2)));
typedef unsigned u32x4 __attribute__((ext_vector_type(4)));
typedef unsigned u32x2 __attribute__((ext_vector_type(2)));

constexpr int BATCH = 2, SEQ = 8192, MTOK = BATCH * SEQ, DM = 1024;
constexpr int NMEM = 256, HD = 64;
constexpr int NSA_N = 2212, NSA_NP = 2304;
constexpr int RWKV_N = 2816, FFN_H = 2816, FFN_N2 = 5632;
constexpr int PRIM = 768;
constexpr float NORM_EPS = 1e-6f;
constexpr int NTHREADS = 512, NWAVES = 8;
constexpr int LDS_BYTES = 147456;
#ifndef REP_ATT
#define REP_ATT 1
#endif
#ifndef REP_RWKV
#define REP_RWKV 1
#endif

constexpr size_t MiB = 1u << 20;
constexpr size_t WS_WT_NSA = 1 * MiB, WS_WT_RWKV = 6 * MiB, WS_WT_OUT = 12 * MiB, WS_WT_FIN = 16 * MiB, WS_WT_FOUT = 38 * MiB;
constexpr size_t WS_WT_C1K = 49 * MiB, WS_WT_C1V = 50 * MiB, WS_WT_MKV = 51 * MiB;
constexpr size_t WS_MEMN = 52 * MiB, WS_MKV = 53 * MiB, WS_COS = 53 * MiB + 512 * 1024, WS_SIN = 54 * MiB;
constexpr size_t WS_KC = 54 * MiB + 512 * 1024, WS_VC = 55 * MiB, WS_BIASK = 55 * MiB + 512 * 1024, WS_BIASV = WS_BIASK + 4096;
constexpr size_t WS_MVT = 55 * MiB + 576 * 1024;
constexpr size_t WS_W2T = 62 * MiB, WS_A2T = 62 * MiB + 128 * 1024, WS_G2T = 62 * MiB + 256 * 1024;
constexpr size_t WS_RKM = 64 * MiB, WS_RKG = 216 * MiB;
constexpr size_t WS_GATES = 56 * MiB, WS_CMPHK = 59 * MiB, WS_CMPHV = 60 * MiB + 512 * 1024;
constexpr size_t WS_HN_A = 64 * MiB, WS_OA = 96 * MiB, WS_FF = 64 * MiB;
constexpr size_t WS_Q = 128 * MiB, WS_KV6 = 152 * MiB, WS_QM = 188 * MiB;
constexpr size_t WS_MIX0 = 192 * MiB, WS_MIX1 = 128 * MiB, WS_ACT = 128 * MiB, WS_HN_B = 216 * MiB, WS_PROJ1 = 128 * MiB;
constexpr size_t KV6_STRIDE = (size_t)BATCH * 3 * SEQ * HD;

__device__ __forceinline__ unsigned f2bf(float f) { unsigned u = __builtin_bit_cast(unsigned, f); return (u + 0x7fffu + ((u >> 16) & 1u)) >> 16; }
__device__ __forceinline__ unsigned pk2(float lo, float hi) { return f2bf(lo) | (f2bf(hi) << 16); }
__device__ __forceinline__ float bf_lo(unsigned u) { return __builtin_bit_cast(float, u << 16); }
__device__ __forceinline__ float bf_hi(unsigned u) { return __builtin_bit_cast(float, u & 0xffff0000u); }
__device__ __forceinline__ float bf2f(bf16_t h) { return __builtin_bit_cast(float, (unsigned)h << 16); }
__device__ __forceinline__ float wave_sum(float v) {
#pragma unroll
    for (int o = 1; o < 64; o <<= 1) v += __shfl_xor(v, o);
    return v;
}
__device__ __forceinline__ float wave_max(float v) {
#pragma unroll
    for (int o = 1; o < 64; o <<= 1) v = fmaxf(v, __shfl_xor(v, o));
    return v;
}
__device__ __forceinline__ float sigmoidf_(float x) { return 1.0f / (1.0f + __expf(-x)); }
__device__ __forceinline__ float gelu_tanh(float x) { return 0.5f * x * (1.0f + tanhf(0.7978845608028654f * (x + 0.044715f * x * x * x))); }
#define LDS_FENCE() asm volatile("s_waitcnt lgkmcnt(0)" ::: "memory")

namespace pg8 {
constexpr int BM = 256, BK = 64, HALF = 128, HTB = HALF * BK * 2, STAGE_BYTES = 8 * HTB, NXCD = 8, WGM = 8;
__host__ __device__ __forceinline__ int lds_byte(int r, int c) { const int st = (r >> 4) * 2 + (c >> 5), rr = r & 15, cc = c & 31, ob = rr * 64 + cc * 2; return st * 1024 + (ob ^ (((ob >> 9) & 1) << 5)); }
__host__ __device__ __forceinline__ void stage_rc(int b, int& R, int& C) { const int st = b / 1024, sb = b % 1024, swz = sb ^ (((sb >> 9) & 1) << 5); R = (st >> 1) * 16 + swz / 64; C = (st & 1) * 32 + (swz % 64) / 2; }
__host__ __device__ __forceinline__ int perm32(int rho) { const int n = rho >> 4, i = rho & 15; return 8 * (i >> 2) + 4 * n + (i & 3); }

struct Unit { int pm, pn; };
struct Gemm { const bf16_t* A; const bf16_t* Bt; int M, N, K, lda; };

struct StaticOrder {
    int nM, nN, nwg, G, c;
    __device__ void init(int M, int N, int G_, int c_) { nM = M / BM; nN = N / BM; nwg = nM * nN; G = G_; c = c_; }
    __device__ bool next(int i, Unit& u) const {
        const long L = (long)i * G + c; if (L >= nwg) return false;
        int wgid = (int)L; { const int q = nwg / NXCD, r = nwg % NXCD, xcd = wgid % NXCD, off = wgid / NXCD; wgid = (xcd < r ? xcd * (q + 1) : r * (q + 1) + (xcd - r) * q) + off; }
        const int nig = WGM * nN, gid = wgid / nig, fm = gid * WGM, gsz = (nM - fm) < WGM ? (nM - fm) : WGM;
        u.pm = fm + ((wgid % nig) % gsz); u.pn = (wgid % nig) / gsz; return true;
    }
};

template <class Epi, bool ALIGN_EPI>
__device__ __forceinline__ void gemm_phase(LAS unsigned char* lds, const Gemm g, const StaticOrder& S, const Epi& E) {
    int tid_ = threadIdx.x; asm volatile("" : "+v"(tid_));
    const int tid = tid_, wid = __builtin_amdgcn_readfirstlane(tid >> 6), lane = tid & 63, wr = wid >> 2, wc = wid & 3, fr = lane & 15, fq = lane >> 4;
    const int K = g.K, nt = K / BK, lda = g.lda;
    unsigned voffA[2], voffB[2];
#pragma unroll
    for (int i = 0; i < 2; ++i) { int R, C; stage_rc(tid * 16 + i * 8192, R, C); const int Rb = Epi::PERM ? ((R & ~31) + perm32(R & 31)) : R;
        voffA[i] = (unsigned)(R * lda + C) * 2u; voffB[i] = (unsigned)(Rb * K + C) * 2u; }
    const size_t kstep = (size_t)(BK * 2);
    const size_t hstepA = (size_t)HALF * lda * 2, hstepB = (size_t)HALF * K * 2;
    const size_t tstepA = 2 * hstepA, tstepB = 2 * hstepB;
    const unsigned ldsw = (unsigned)wid * 1024u;
    const int aoff = lds_byte(wr * 64 + fr, fq * 8), boff = lds_byte(wc * 32 + fr, fq * 8);
#define PG8_SA(b, h) (((b) * 2 + (h)) * HTB)
#define PG8_SB(b, h) ((4 + (b) * 2 + (h)) * HTB)
#define PG8_STAGE(bufoff, gbase, voff) do { _Pragma("unroll") for (int _i = 0; _i < 2; ++_i) \
        __builtin_amdgcn_global_load_lds((const unsigned*)((const char*)(gbase) + (voff)[_i]), (LAS unsigned*)(lds + (bufoff) + ldsw + _i * 8192), 16, 0, 0); } while (0)
#define PG8_LDA(dst, b, h) do { _Pragma("unroll") for (int m = 0; m < 4; ++m) _Pragma("unroll") for (int k = 0; k < 2; ++k) dst[m][k] = *(const LAS bf16x8*)(lds + PG8_SA(b, h) + aoff + m * 2048 + k * 1024); } while (0)
#define PG8_LDB(dst, b, h) do { _Pragma("unroll") for (int n = 0; n < 2; ++n) _Pragma("unroll") for (int k = 0; k < 2; ++k) dst[n][k] = *(const LAS bf16x8*)(lds + PG8_SB(b, h) + boff + n * 2048 + k * 1024); } while (0)
#define PG8_MMA(ai, bj, At, Bt) do { __builtin_amdgcn_s_setprio(1); _Pragma("unroll") for (int m = 0; m < 4; ++m) _Pragma("unroll") for (int n = 0; n < 2; ++n) _Pragma("unroll") for (int k = 0; k < 2; ++k) \
        acc[ai][bj][m][n] = __builtin_amdgcn_mfma_f32_16x16x32_bf16(Bt[n][k], At[m][k], acc[ai][bj][m][n], 0, 0, 0); __builtin_amdgcn_s_setprio(0); } while (0)
#define PG8_WAIT_V(n) asm volatile("s_waitcnt vmcnt(" #n ")" ::: "memory")
#define PG8_WAIT_L(n) asm volatile("s_waitcnt lgkmcnt(" #n ")" ::: "memory")
#define PG8_BAR __builtin_amdgcn_s_barrier()
#define PG8_SCHED __builtin_amdgcn_sched_barrier(0)
    Unit cur, nxt; int ui = 0;
    if (!S.next(0, cur)) return;
    f32x4 acc[2][2][4][2];
#pragma unroll
    for (int a = 0; a < 2; ++a)
#pragma unroll
        for (int b = 0; b < 2; ++b)
#pragma unroll
            for (int m = 0; m < 4; ++m)
#pragma unroll
                for (int n = 0; n < 2; ++n) acc[a][b][m][n] = (f32x4){0.f, 0.f, 0.f, 0.f};
    bf16x8 At[4][2], B0[2][2], B1[2][2];
    const char* cA = (const char*)g.A + (size_t)cur.pm * tstepA; const char* cB = (const char*)g.Bt + (size_t)cur.pn * tstepB;
    PG8_STAGE(PG8_SB(0, 0), cB, voffB); PG8_STAGE(PG8_SB(0, 1), cB + hstepB, voffB); PG8_STAGE(PG8_SA(0, 0), cA, voffA); PG8_STAGE(PG8_SA(0, 1), cA + hstepA, voffA);
    if (wr == 1) PG8_BAR;
    PG8_WAIT_V(2); PG8_BAR;
    PG8_STAGE(PG8_SB(1, 0), cB + kstep, voffB); PG8_STAGE(PG8_SA(1, 0), cA + kstep, voffA); PG8_STAGE(PG8_SB(1, 1), cB + hstepB + kstep, voffB);
    PG8_WAIT_V(6); PG8_BAR;
    for (;;) {
        const bool has_next = S.next(ui + 1, nxt);
        const char* nA = has_next ? (const char*)g.A + (size_t)nxt.pm * tstepA : cA; const char* nB = has_next ? (const char*)g.Bt + (size_t)nxt.pn * tstepB : cB;
        for (int t = 0; t < nt; t += 2) {
            const bool last = (t == nt - 2);
            const char* a1 = cA + (size_t)(t + 1) * kstep;
            const char* a2 = last ? nA : cA + (size_t)(t + 2) * kstep; const char* b2 = last ? nB : cB + (size_t)(t + 2) * kstep;
            const char* a3 = a2 + kstep; const char* b3 = b2 + kstep;
            PG8_LDB(B0, 0, 0); PG8_LDB(B1, 0, 1); PG8_SCHED; PG8_LDA(At, 0, 0); PG8_STAGE(PG8_SA(1, 1), a1 + hstepA, voffA);
            PG8_WAIT_V(8); PG8_WAIT_L(0); PG8_BAR; PG8_MMA(0, 0, At, B0); PG8_MMA(0, 1, At, B1); PG8_BAR; PG8_SCHED;
            PG8_LDA(At, 0, 1); PG8_STAGE(PG8_SB(0, 0), b2, voffB); PG8_STAGE(PG8_SB(0, 1), b2 + hstepB, voffB); PG8_STAGE(PG8_SA(0, 0), a2, voffA);
            PG8_WAIT_V(8); PG8_WAIT_L(0); PG8_BAR; PG8_MMA(1, 0, At, B0); PG8_MMA(1, 1, At, B1); PG8_BAR; PG8_SCHED;
            PG8_LDB(B0, 1, 0); PG8_LDB(B1, 1, 1); PG8_SCHED; PG8_LDA(At, 1, 0); PG8_STAGE(PG8_SA(0, 1), a2 + hstepA, voffA);
            PG8_WAIT_V(8); PG8_WAIT_L(0); PG8_BAR; PG8_MMA(0, 0, At, B0); PG8_MMA(0, 1, At, B1); PG8_BAR; PG8_SCHED;
            PG8_LDA(At, 1, 1); PG8_STAGE(PG8_SB(1, 0), b3, voffB); PG8_STAGE(PG8_SB(1, 1), b3 + hstepB, voffB); PG8_STAGE(PG8_SA(1, 0), a3, voffA);
            PG8_WAIT_V(8); PG8_WAIT_L(0); PG8_BAR; PG8_MMA(1, 0, At, B0); PG8_MMA(1, 1, At, B1); PG8_BAR; PG8_SCHED;
        }
        if constexpr (ALIGN_EPI) { if (wr == 0) PG8_BAR; }
        { int fr2 = fr, fq2 = fq; asm volatile("" : "+v"(fr2), "+v"(fq2)); E(acc, cur, wr, wc, fr2, fq2); }
        if (!has_next) break;
#pragma unroll
        for (int a = 0; a < 2; ++a)
#pragma unroll
            for (int b = 0; b < 2; ++b)
#pragma unroll
                for (int m = 0; m < 4; ++m)
#pragma unroll
                    for (int n = 0; n < 2; ++n) acc[a][b][m][n] = (f32x4){0.f, 0.f, 0.f, 0.f};
        cur = nxt; cA = nA; cB = nB; ++ui;
        if constexpr (ALIGN_EPI) { if (wr == 1) PG8_BAR; }
    }
    PG8_WAIT_V(0);
    if constexpr (!ALIGN_EPI) { if (wr == 0) PG8_BAR; }
    PG8_BAR;
#undef PG8_SA
#undef PG8_SB
#undef PG8_STAGE
#undef PG8_LDA
#undef PG8_LDB
#undef PG8_MMA
#undef PG8_WAIT_V
#undef PG8_WAIT_L
#undef PG8_BAR
#undef PG8_SCHED
}

struct EpiBf16 {
    static constexpr bool PERM = true;
    bf16_t* O; int ldc;
    __device__ __forceinline__ void operator()(const f32x4 (&acc)[2][2][4][2], const Unit& u, int wr, int wc, int fr, int fq) const {
        const int row0 = u.pm * BM + wr * 64 + fr, col0 = u.pn * BM + wc * 32 + 8 * fq;
#pragma unroll
        for (int ai = 0; ai < 2; ++ai)
#pragma unroll
            for (int m = 0; m < 4; ++m) { bf16_t* rowp = O + (size_t)(row0 + ai * HALF + m * 16) * ldc + col0;
#pragma unroll
                for (int bj = 0; bj < 2; ++bj) { const f32x4 v0 = acc[ai][bj][m][0], v1 = acc[ai][bj][m][1];
                    u32x4 w; w.x = pk2(v0[0], v0[1]); w.y = pk2(v0[2], v0[3]); w.z = pk2(v1[0], v1[1]); w.w = pk2(v1[2], v1[3]);
                    *(u32x4*)(rowp + bj * HALF) = w; } }
    }
};
struct EpiGeluBias {
    static constexpr bool PERM = true;
    bf16_t* O; int ldc; const float* bias;
    __device__ __forceinline__ void operator()(const f32x4 (&acc)[2][2][4][2], const Unit& u, int wr, int wc, int fr, int fq) const {
        const int row0 = u.pm * BM + wr * 64 + fr, col0 = u.pn * BM + wc * 32 + 8 * fq;
#pragma unroll
        for (int bj = 0; bj < 2; ++bj) {
            const f32x4 b0 = *(const f32x4*)(bias + col0 + bj * HALF), b1 = *(const f32x4*)(bias + col0 + bj * HALF + 4);
#pragma unroll
            for (int ai = 0; ai < 2; ++ai)
#pragma unroll
                for (int m = 0; m < 4; ++m) { bf16_t* rowp = O + (size_t)(row0 + ai * HALF + m * 16) * ldc + col0 + bj * HALF;
                    const f32x4 v0 = acc[ai][bj][m][0] + b0, v1 = acc[ai][bj][m][1] + b1;
                    u32x4 w; w.x = pk2(gelu_tanh(v0[0]), gelu_tanh(v0[1])); w.y = pk2(gelu_tanh(v0[2]), gelu_tanh(v0[3]));
                    w.z = pk2(gelu_tanh(v1[0]), gelu_tanh(v1[1])); w.w = pk2(gelu_tanh(v1[2]), gelu_tanh(v1[3]));
                    *(u32x4*)rowp = w; } }
    }
};
struct EpiSwiglu {
    static constexpr bool PERM = true;
    bf16_t* O; int ldc;
    __device__ __forceinline__ void operator()(const f32x4 (&acc)[2][2][4][2], const Unit& u, int wr, int wc, int fr, int fq) const {
        const int row0 = u.pm * BM + wr * 64 + fr, col0 = u.pn * HALF + wc * 32 + 8 * fq;
#pragma unroll
        for (int ai = 0; ai < 2; ++ai)
#pragma unroll
            for (int m = 0; m < 4; ++m) { bf16_t* rowp = O + (size_t)(row0 + ai * HALF + m * 16) * ldc + col0;
                float r[8];
#pragma unroll
                for (int n = 0; n < 2; ++n)
#pragma unroll
                    for (int i = 0; i < 4; ++i) { const float gg = acc[ai][0][m][n][i], uu = acc[ai][1][m][n][i]; r[n * 4 + i] = gg / (1.0f + __expf(-gg)) * uu; }
                u32x4 w; w.x = pk2(r[0], r[1]); w.y = pk2(r[2], r[3]); w.z = pk2(r[4], r[5]); w.w = pk2(r[6], r[7]);
                *(u32x4*)rowp = w; }
    }
};
struct EpiF32 {
    static constexpr bool PERM = false;
    float* O; int ldc;
    __device__ __forceinline__ void operator()(const f32x4 (&acc)[2][2][4][2], const Unit& u, int wr, int wc, int fr, int fq) const {
        const int col0 = u.pn * BM + wc * 32 + 4 * fq;
#pragma unroll
        for (int ai = 0; ai < 2; ++ai)
#pragma unroll
            for (int m = 0; m < 4; ++m) { const int r = ai * HALF + wr * 64 + m * 16 + fr; float* rowp = O + (size_t)(u.pm * BM + r) * ldc + col0;
#pragma unroll
                for (int bj = 0; bj < 2; ++bj)
#pragma unroll
                    for (int n = 0; n < 2; ++n) *(f32x4*)(rowp + bj * HALF + n * 16) = acc[ai][bj][m][n]; }
    }
};
struct EpiNsaSplit {
    static constexpr bool PERM = true;
    bf16_t* Q; bf16_t* KV6; bf16_t* QM; float* GATES; const float* gate_b;
    __device__ __forceinline__ void operator()(const f32x4 (&acc)[2][2][4][2], const Unit& u, int wr, int wc, int fr, int fq) const {
        const int row0 = u.pm * BM + wr * 64 + fr;
#pragma unroll
        for (int bj = 0; bj < 2; ++bj) {
            const int c = u.pn * BM + bj * HALF + wc * 32 + 8 * fq;
#pragma unroll
            for (int ai = 0; ai < 2; ++ai)
#pragma unroll
                for (int m = 0; m < 4; ++m) {
                    const int row = row0 + ai * HALF + m * 16;
                    const f32x4 v0 = acc[ai][bj][m][0], v1 = acc[ai][bj][m][1];
                    if (c < 2176) {
                        bf16_t* dst;
                        if (c < 768) dst = Q + (size_t)row * 768 + c;
                        else if (c < 1920) { const int cc = c - 768, idx = cc / 192, rem = cc % 192, gg = rem >> 6, d = rem & 63, b = row >> 13, s = row & 8191;
                            if (idx == 3 || idx == 5) {
                                bf16_t* tp = KV6 + (size_t)idx * KV6_STRIDE + ((size_t)(b * 3 + gg) * HD + d) * SEQ + s;
#pragma unroll
                                for (int e = 0; e < 8; ++e) tp[(size_t)e * SEQ] = (bf16_t)f2bf(e < 4 ? v0[e & 3] : v1[e & 3]);
                                continue; }
                            dst = KV6 + (size_t)idx * KV6_STRIDE + ((size_t)(b * 3 + gg) * SEQ + s) * HD + d; }
                        else dst = QM + (size_t)row * 256 + (c - 1920);
                        u32x4 w; w.x = pk2(v0[0], v0[1]); w.y = pk2(v0[2], v0[3]); w.z = pk2(v1[0], v1[1]); w.w = pk2(v1[2], v1[3]);
                        *(u32x4*)dst = w;
                    } else if (c < 2212) {
#pragma unroll
                        for (int e = 0; e < 8; ++e) { const int cgi = c - 2176 + e; const float v = e < 4 ? v0[e & 3] : v1[e & 3];
                            if (cgi < 36) GATES[(size_t)row * 36 + cgi] = sigmoidf_(v + gate_b[cgi]); }
                    }
                }
        }
    }
};
}

struct Args { const float* in[32]; float* out; unsigned char* ws; };

template <class RowMap>
__device__ __forceinline__ void transpose_item(const float* W, int K, int N, bf16_t* WT, const RowMap& rm, LAS float* scr, int item, int lane) {
    const int nblk = (N + 31) / 32, kb = item / nblk, nb = item % nblk, k0 = 64 * kb, n0 = 32 * nb;
    const int nn = n0 + (lane & 31);
#pragma unroll 8
    for (int i = 0; i < 32; ++i) { const int kk = 2 * i + (lane >> 5); scr[kk * 33 + (lane & 31)] = (nn < N) ? W[(size_t)(k0 + kk) * N + nn] : 0.f; }
    LDS_FENCE();
    const int c = lane & 7;
#pragma unroll
    for (int j = 0; j < 4; ++j) { const int n = (lane >> 3) + 8 * j; const LAS float* s = scr + (8 * c) * 33 + n;
        u32x4 o; o.x = pk2(s[0 * 33], s[1 * 33]); o.y = pk2(s[2 * 33], s[3 * 33]); o.z = pk2(s[4 * 33], s[5 * 33]); o.w = pk2(s[6 * 33], s[7 * 33]);
        if (n0 + n < N) *(u32x4*)(WT + (size_t)rm(n0 + n) * K + k0 + 8 * c) = o; }
    LDS_FENCE();
}
struct MapId { __device__ __forceinline__ int operator()(int n) const { return n; } };
struct MapNsa { __device__ __forceinline__ int operator()(int n) const { return n < 1920 ? n : (n < 1956 ? n - 1920 + 2176 : n - 1956 + 1920); } };
struct MapFfn { __device__ __forceinline__ int operator()(int n) const { const int j = n < FFN_H ? n : n - FFN_H; return (j >> 7) * 256 + (n < FFN_H ? 0 : 128) + (j & 127); } };

__device__ __forceinline__ void rms_row_to_bf16(const float* xrow, const float* g, bf16_t* orow, int lane) {
    const f32x4* xr = (const f32x4*)xrow + lane; const f32x4* gr = (const f32x4*)g + lane;
    f32x4 v[4]; float s = 0.f;
#pragma unroll
    for (int j = 0; j < 4; ++j) { v[j] = xr[64 * j]; s += (v[j].x * v[j].x + v[j].y * v[j].y) + (v[j].z * v[j].z + v[j].w * v[j].w); }
    const float r = rsqrtf(wave_sum(s) * (1.f / DM) + NORM_EPS);
    u32x2* o8 = (u32x2*)orow + lane;
#pragma unroll
    for (int j = 0; j < 4; ++j) { const f32x4 gg = gr[64 * j]; u32x2 w; w.x = pk2(v[j].x * r * gg.x, v[j].y * r * gg.y); w.y = pk2(v[j].z * r * gg.z, v[j].w * r * gg.w); o8[64 * j] = w; }
}
__device__ __forceinline__ void res_row(const float* base, const float* y, const float* gpost, const float* gnext, float* out, bf16_t* hn, int lane) {
    const f32x4* yr = (const f32x4*)y + lane; const f32x4* br = (const f32x4*)base + lane; const f32x4* gp = (const f32x4*)gpost + lane;
    f32x4 v[4]; float s = 0.f;
#pragma unroll
    for (int j = 0; j < 4; ++j) { v[j] = yr[64 * j]; s += (v[j].x * v[j].x + v[j].y * v[j].y) + (v[j].z * v[j].z + v[j].w * v[j].w); }
    const float r = rsqrtf(wave_sum(s) * (1.f / DM) + NORM_EPS);
    float s2 = 0.f;
#pragma unroll
    for (int j = 0; j < 4; ++j) { const f32x4 gg = gp[64 * j], bb = br[64 * j]; v[j] = bb + v[j] * r * gg; s2 += (v[j].x * v[j].x + v[j].y * v[j].y) + (v[j].z * v[j].z + v[j].w * v[j].w); }
    f32x4* orow = (f32x4*)out + lane;
#pragma unroll
    for (int j = 0; j < 4; ++j) orow[64 * j] = v[j];
    if (hn) {
        const float r2 = rsqrtf(wave_sum(s2) * (1.f / DM) + NORM_EPS);
        const f32x4* gn = (const f32x4*)gnext + lane; u32x2* o8 = (u32x2*)hn + lane;
#pragma unroll
        for (int j = 0; j < 4; ++j) { const f32x4 gg = gn[64 * j]; u32x2 w; w.x = pk2(v[j].x * r2 * gg.x, v[j].y * r2 * gg.y); w.y = pk2(v[j].z * r2 * gg.z, v[j].w * r2 * gg.w); o8[64 * j] = w; }
    }
}

namespace att {
typedef float f32x16 __attribute__((ext_vector_type(16)));
constexpr int KSTR = 144, VSTR = 136, BUFB = 18432, VOFF = 9216;
constexpr int LDS_IMP = 2 * BUFB;
constexpr int LDS_SELM = LDS_IMP + 32768;
constexpr int LDS_MISC = LDS_SELM + 1024;
constexpr float C2 = 0.125f * 1.4426950408889634f;
constexpr float NEGBIG = -1e30f;

__device__ __forceinline__ int crow(int r, int hi) { return (r & 3) + 8 * (r >> 2) + 4 * hi; }
struct Src { const bf16_t* K; int kstride; const bf16_t* Vt; int vstride; };
struct Acc { float m, l; f32x16 o0, o1; };

__device__ __forceinline__ void tile_load(u32x4& kreg, u32x4& vreg, const Src& s, int key0, int tid, bool withV) {
    const int row = tid >> 3, ch = tid & 7;
    kreg = *(const u32x4*)(s.K + (size_t)(key0 + row) * s.kstride + ch * 8);
    if (withV) vreg = *(const u32x4*)(s.Vt + (size_t)row * s.vstride + key0 + ch * 8);
}
__device__ __forceinline__ void tile_store(LAS unsigned char* lds, int buf, const u32x4& kreg, const u32x4& vreg, int tid, bool withV) {
    const int row = tid >> 3, ch = tid & 7;
    *(LAS u32x4*)(lds + buf * BUFB + row * KSTR + ch * 16) = kreg;
    if (withV) { LAS u32x2* p = (LAS u32x2*)(lds + buf * BUFB + VOFF + row * VSTR + ch * 16); p[0] = (u32x2){vreg.x, vreg.y}; p[1] = (u32x2){vreg.z, vreg.w}; }
}
__device__ __forceinline__ void qk_tile(f32x16& S0, f32x16& S1, const LAS unsigned char* kl, const bf16x8 (&qr)[4], float bias, int r32, int hi) {
#pragma unroll
    for (int r = 0; r < 16; ++r) { S0[r] = bias; S1[r] = bias; }
    const LAS unsigned char* p = kl + r32 * KSTR + hi * 16;
#pragma unroll
    for (int d0 = 0; d0 < 4; ++d0) {
        const bf16x8 a0 = *(const LAS bf16x8*)(p + d0 * 32), a1 = *(const LAS bf16x8*)(p + 32 * KSTR + d0 * 32);
        S0 = __builtin_amdgcn_mfma_f32_32x32x16_bf16(a0, qr[d0], S0, 0, 0, 0);
        S1 = __builtin_amdgcn_mfma_f32_32x32x16_bf16(a1, qr[d0], S1, 0, 0, 0);
    }
}
__device__ __forceinline__ void mask_tile(f32x16& S0, f32x16& S1, int lo, int hi_, int hi) {
#pragma unroll
    for (int r = 0; r < 16; ++r) { const int kl = crow(r, hi);
        if (kl < lo || kl > hi_) S0[r] = -INFINITY;
        if (kl + 32 < lo || kl + 32 > hi_) S1[r] = -INFINITY; }
}
__device__ __forceinline__ float tile_max(const f32x16& S0, const f32x16& S1) {
    float a = fmaxf(S0[0], S1[0]);
#pragma unroll
    for (int r = 1; r < 16; ++r) a = fmaxf(a, fmaxf(S0[r], S1[r]));
    return fmaxf(a, __shfl_xor(a, 32));
}
__device__ __forceinline__ void pv_tile(f32x16& o0, f32x16& o1, const f32x16& S0, const f32x16& S1, const LAS unsigned char* vl, int r32, int hi) {
    bf16x8 pf[4];
#pragma unroll
    for (int s = 0; s < 4; ++s) { u32x4 w;
#pragma unroll
        for (int e = 0; e < 4; ++e) { const int r = (s & 1) * 8 + e * 2; w[e] = (s < 2) ? pk2(S0[r], S0[r + 1]) : pk2(S1[r], S1[r + 1]); }
        pf[s] = __builtin_bit_cast(bf16x8, w); }
    const LAS unsigned char* p = vl + r32 * VSTR + hi * 8;
#pragma unroll
    for (int s = 0; s < 4; ++s) {
        const u32x2 a0 = *(const LAS u32x2*)(p + s * 32), a1 = *(const LAS u32x2*)(p + s * 32 + 16);
        const u32x2 b0 = *(const LAS u32x2*)(p + 32 * VSTR + s * 32), b1 = *(const LAS u32x2*)(p + 32 * VSTR + s * 32 + 16);
        const bf16x8 va = __builtin_bit_cast(bf16x8, (u32x4){a0.x, a0.y, a1.x, a1.y}), vb = __builtin_bit_cast(bf16x8, (u32x4){b0.x, b0.y, b1.x, b1.y});
        o0 = __builtin_amdgcn_mfma_f32_32x32x16_bf16(va, pf[s], o0, 0, 0, 0);
        o1 = __builtin_amdgcn_mfma_f32_32x32x16_bf16(vb, pf[s], o1, 0, 0, 0);
    }
}
template <int MODE>
__device__ __forceinline__ void run_tiles(LAS unsigned char* lds, const Src& src, int tb, int te, const bf16x8 (&qr)[4], Acc& A, int tid, int r32, int hi, int ql, int aux, float invl) {
    constexpr bool withV = (MODE != 0);
    if (tb >= te) return;
    u32x4 kreg, vreg = (u32x4){0u, 0u, 0u, 0u};
    tile_load(kreg, vreg, src, tb * 64, tid, withV);
    for (int i = tb; i < te; ++i) {
        const int buf = i & 1;
        tile_store(lds, buf, kreg, vreg, tid, withV);
        if (i + 1 < te) tile_load(kreg, vreg, src, (i + 1) * 64, tid, withV);
        __syncthreads();
        float bias = 0.f; int lo = 0, hi_ = 63;
        if (MODE == 2) { if (i < aux) { const unsigned wb = ((const LAS unsigned*)(lds + LDS_SELM))[ql * 4 + (i >> 5)]; bias = ((wb >> (i & 31)) & 1u) ? 0.f : -INFINITY; } else hi_ = ql; }
        if (MODE == 3) { if (i == aux) hi_ = ql; if (i == aux - 8) lo = ql + 1; }
        if (MODE == 0 || MODE == 1) hi_ = aux - 64 * i;
        const bool skip = (MODE == 2) && __all(bias != 0.f);
        if (!skip) {
            f32x16 S0, S1;
            qk_tile(S0, S1, lds + buf * BUFB, qr, bias, r32, hi);
            if (!__all(lo <= 0 && hi_ >= 63)) mask_tile(S0, S1, lo, hi_, hi);
            if (MODE == 1) {
#pragma unroll
                for (int r = 0; r < 16; ++r) { S0[r] = __builtin_amdgcn_exp2f(S0[r] - A.m) * invl; S1[r] = __builtin_amdgcn_exp2f(S1[r] - A.m) * invl; }
                LAS float* imp = (LAS float*)(lds + LDS_IMP) + ql * 128;
#pragma unroll
                for (int rt = 0; rt < 2; ++rt)
#pragma unroll
                    for (int mg = 0; mg < 4; ++mg) {
                        const float p0 = rt ? S1[4 * mg] : S0[4 * mg], p1 = rt ? S1[4 * mg + 1] : S0[4 * mg + 1], p2 = rt ? S1[4 * mg + 2] : S0[4 * mg + 2], p3 = rt ? S1[4 * mg + 3] : S0[4 * mg + 3];
                        float av = 2.f * (p0 + p1 + p2) + p3, bv = p3;
                        av += __shfl_xor(av, 1); av += __shfl_xor(av, 2); bv += __shfl_xor(bv, 1); bv += __shfl_xor(bv, 2);
                        if ((r32 & 3) == 0) { const int j = (64 * i + 32 * rt + 8 * mg + 4 * hi) >> 2;
                            if (j < 128) { __hip_atomic_fetch_add(imp + j, av, __ATOMIC_RELAXED, __HIP_MEMORY_SCOPE_WORKGROUP);
                                if (j + 1 < 128) __hip_atomic_fetch_add(imp + j + 1, bv, __ATOMIC_RELAXED, __HIP_MEMORY_SCOPE_WORKGROUP); } }
                    }
                pv_tile(A.o0, A.o1, S0, S1, lds + buf * BUFB + VOFF, r32, hi);
            } else {
                const float rm = tile_max(S0, S1);
                const float mn = fmaxf(A.m, rm);
                const float alpha = __builtin_amdgcn_exp2f(A.m - mn);
                A.m = mn;
                float ls = 0.f;
#pragma unroll
                for (int r = 0; r < 16; ++r) { S0[r] = __builtin_amdgcn_exp2f(S0[r] - mn); S1[r] = __builtin_amdgcn_exp2f(S1[r] - mn); ls += S0[r] + S1[r]; }
                A.l = A.l * alpha + ls;
                if (MODE != 0) {
                    if (!__all(alpha == 1.0f)) {
#pragma unroll
                        for (int r = 0; r < 16; ++r) { A.o0[r] *= alpha; A.o1[r] *= alpha; } }
                    pv_tile(A.o0, A.o1, S0, S1, lds + buf * BUFB + VOFF, r32, hi);
                }
            }
        }
    }
    __syncthreads();
}
__device__ __forceinline__ void load_q(bf16x8 (&qr)[4], const bf16_t* qp) {
#pragma unroll
    for (int d0 = 0; d0 < 4; ++d0) { const u32x4 raw = *(const u32x4*)(qp + d0 * 16); u32x4 w;
#pragma unroll
        for (int e = 0; e < 4; ++e) w[e] = pk2(bf_lo(raw[e]) * C2, bf_hi(raw[e]) * C2);
        qr[d0] = __builtin_bit_cast(bf16x8, w); }
}
__device__ __forceinline__ void acc_reset(Acc& A) { A.m = NEGBIG; A.l = 0.f;
#pragma unroll
    for (int r = 0; r < 16; ++r) { A.o0[r] = 0.f; A.o1[r] = 0.f; } }
__device__ __forceinline__ void store_out(bf16_t* orow, const f32x16& o0, const f32x16& o1, int hi) {
#pragma unroll
    for (int rg = 0; rg < 4; ++rg) {
        *(u32x2*)(orow + 8 * rg + 4 * hi) = (u32x2){pk2(o0[4 * rg], o0[4 * rg + 1]), pk2(o0[4 * rg + 2], o0[4 * rg + 3])};
        *(u32x2*)(orow + 32 + 8 * rg + 4 * hi) = (u32x2){pk2(o1[4 * rg], o1[4 * rg + 1]), pk2(o1[4 * rg + 2], o1[4 * rg + 3])}; }
}

struct NsaP { const bf16_t* Q; const bf16_t* KV6; const bf16_t* KC; const bf16_t* VCt; const float* GATES; bf16_t* OA; };
__device__ __forceinline__ void nsa_unit(const NsaP& P, int b, int g, int blk, LAS unsigned char* lds, int tid) {
    asm volatile("" : "+v"(tid));
    const int lane = tid & 63, wave = __builtin_amdgcn_readfirstlane(tid >> 6), r32 = lane & 31, hi = lane >> 5;
    const int ql = 8 * wave + (r32 >> 2), hh = r32 & 3, t0 = blk * 64, t = t0 + ql, cur = blk;
    const size_t row = (size_t)b * SEQ + t, bg = (size_t)(b * 3 + g);
    bf16x8 qr[4]; load_q(qr, P.Q + row * 768 + (g * 4 + hh) * 64 + hi * 8);
    const float* gp = P.GATES + row * 36 + (g * 4 + hh) * 3; const float g0 = gp[0], g1 = gp[1], g2 = gp[2];
    f32x16 out0, out1;
#pragma unroll
    for (int r = 0; r < 16; ++r) { out0[r] = 0.f; out1[r] = 0.f; }
    { LAS f32x4* z = (LAS f32x4*)(lds + LDS_IMP);
#pragma unroll
      for (int i = 0; i < 4; ++i) z[tid + i * NTHREADS] = (f32x4){0.f, 0.f, 0.f, 0.f}; }
    Acc A;
    {
        const int nvmax = ((t0 >> 4) + 3) > 511 ? 511 : ((t0 >> 4) + 3), ntc = (nvmax + 63) >> 6;
        const int nlim = (t >= 31) ? ((t - 31) >> 4) : -1;
        const Src sc{P.KC + bg * 512 * 64, 64, P.VCt + bg * 64 * 512, 512};
        acc_reset(A);
        run_tiles<0>(lds, sc, 0, ntc, qr, A, tid, r32, hi, ql, nlim, 0.f);
        const float lt = A.l + __shfl_xor(A.l, 32);
        const float invl = lt > 0.f ? 1.0f / lt : 0.f;
        run_tiles<1>(lds, sc, 0, ntc, qr, A, tid, r32, hi, ql, nlim, invl);
#pragma unroll
        for (int r = 0; r < 16; ++r) { out0[r] = g0 * A.o0[r]; out1[r] = g0 * A.o1[r]; }
    }
    {
        LAS float* imp = (LAS float*)(lds + LDS_IMP); LAS unsigned* selm = (LAS unsigned*)(lds + LDS_SELM);
        for (int i = 0; i < 8; ++i) { const int q = 8 * wave + i; unsigned long long m0, m1;
            if (cur < 16) { m0 = (1ull << (cur + 1)) - 1ull; m1 = 0ull; }
            else {
                const float v0 = imp[q * 128 + lane], v1 = imp[q * 128 + 64 + lane]; int r0 = 0, r1 = 0; const int lo = 1, hi_ = cur - 2;
                for (int j = lo; j <= hi_; ++j) { const float v = imp[q * 128 + j]; r0 += (v > v0 || (v == v0 && j < lane)) ? 1 : 0; r1 += (v > v1 || (v == v1 && j < lane + 64)) ? 1 : 0; }
                const bool s0 = lane >= lo && lane <= hi_ && r0 < 13, s1 = (lane + 64) <= hi_ && r1 < 13;
                m0 = __ballot(s0); m1 = __ballot(s1);
                m0 |= 1ull;
                if (cur - 1 < 64) m0 |= 1ull << (cur - 1); else m1 |= 1ull << (cur - 1 - 64);
                if (cur < 64) m0 |= 1ull << cur; else m1 |= 1ull << (cur - 64);
            }
            if (lane == 0) { selm[q * 4 + 0] = (unsigned)m0; selm[q * 4 + 1] = (unsigned)(m0 >> 32); selm[q * 4 + 2] = (unsigned)m1; selm[q * 4 + 3] = (unsigned)(m1 >> 32); } }
        __syncthreads();
    }
    {
        const Src ss{P.KV6 + 2 * KV6_STRIDE + bg * SEQ * 64, 64, P.KV6 + 3 * KV6_STRIDE + bg * 64 * SEQ, SEQ};
        acc_reset(A);
        run_tiles<2>(lds, ss, 0, cur + 1, qr, A, tid, r32, hi, ql, cur, 0.f);
        const float lt = A.l + __shfl_xor(A.l, 32); const float sc = g1 / lt;
#pragma unroll
        for (int r = 0; r < 16; ++r) { out0[r] += sc * A.o0[r]; out1[r] += sc * A.o1[r]; }
    }
    {
        const Src sw{P.KV6 + 4 * KV6_STRIDE + bg * SEQ * 64, 64, P.KV6 + 5 * KV6_STRIDE + bg * 64 * SEQ, SEQ};
        acc_reset(A);
        run_tiles<3>(lds, sw, cur - 8 > 0 ? cur - 8 : 0, cur + 1, qr, A, tid, r32, hi, ql, cur, 0.f);
        const float lt = A.l + __shfl_xor(A.l, 32); const float sc = g2 / lt;
#pragma unroll
        for (int r = 0; r < 16; ++r) { out0[r] += sc * A.o0[r]; out1[r] += sc * A.o1[r]; }
    }
    store_out(P.OA + row * 1024 + (g * 4 + hh) * 64, out0, out1, hi);
}
__device__ __forceinline__ void mem_unit(const bf16_t* Qsrc, int qstride, const bf16_t* MKVp, const bf16_t* MVt, bf16_t* OAp, int b, int tb, int h, LAS unsigned char* lds, int tid) {
    asm volatile("" : "+v"(tid));
    const int lane = tid & 63, wave = __builtin_amdgcn_readfirstlane(tid >> 6), r32 = lane & 31, hi = lane >> 5;
    const size_t row = (size_t)b * SEQ + tb * 256 + 32 * wave + r32;
    bf16x8 qr[4]; load_q(qr, Qsrc + row * qstride + h * 64 + hi * 8);
    const Src sm{MKVp + (size_t)b * 256 * 512 + h * 64, 512, MVt + ((size_t)b * 256 + h * 64) * 256, 256};
    Acc A; acc_reset(A);
    run_tiles<4>(lds, sm, 0, 4, qr, A, tid, r32, hi, 0, 0, 0.f);
    const float lt = A.l + __shfl_xor(A.l, 32); const float sc = 1.0f / lt;
#pragma unroll
    for (int r = 0; r < 16; ++r) { A.o0[r] *= sc; A.o1[r] *= sc; }
    store_out(OAp + row * 1024 + 768 + h * 64, A.o0, A.o1, hi);
}
}

namespace rk {
constexpr int STR = 72, SLOT = 64 * STR * 2;
constexpr int OFF_DG = 15 * SLOT, OFF_GS = OFF_DG + 4 * 16 * 17 * 4, OFF_PC = OFF_GS + 8 * 64 * 4, OFF_BON = OFF_PC + 256;
static_assert(OFF_BON + 256 <= LDS_BYTES, "rk lds");
struct MM { f32x4 c[2]; };
__device__ __forceinline__ void mm_zero(MM& m) { m.c[0] = (f32x4){0.f, 0.f, 0.f, 0.f}; m.c[1] = (f32x4){0.f, 0.f, 0.f, 0.f}; }
__device__ __forceinline__ void mm_acc(MM& m, const LAS unsigned char* G, const LAS unsigned char* H, int wave, int lane) {
    const int l15 = lane & 15, q = lane >> 4, yt = wave & 3, xt0 = 2 * (wave >> 2);
    const LAS unsigned char* hp = H + (16 * yt + l15) * (STR * 2) + q * 16;
    const LAS unsigned char* gp = G + (16 * xt0 + l15) * (STR * 2) + q * 16;
#pragma unroll
    for (int ks = 0; ks < 2; ++ks) {
        const bf16x8 av = *(const LAS bf16x8*)(hp + ks * 64);
#pragma unroll
        for (int t = 0; t < 2; ++t) { const bf16x8 bv = *(const LAS bf16x8*)(gp + t * 16 * (STR * 2) + ks * 64);
            m.c[t] = __builtin_amdgcn_mfma_f32_16x16x32_bf16(av, bv, m.c[t], 0, 0, 0); }
    }
}
__device__ __forceinline__ void mm_acc_gl(MM& m, const LAS unsigned char* G, const bf16_t* Hg, int ldh, int wave, int lane) {
    const int l15 = lane & 15, q = lane >> 4, yt = wave & 3, xt0 = 2 * (wave >> 2);
    const bf16_t* hp = Hg + (size_t)(16 * yt + l15) * ldh + q * 8;
    const LAS unsigned char* gp = G + (16 * xt0 + l15) * (STR * 2) + q * 16;
#pragma unroll
    for (int ks = 0; ks < 2; ++ks) {
        const bf16x8 av = *(const bf16x8*)(hp + ks * 32);
#pragma unroll
        for (int t = 0; t < 2; ++t) { const bf16x8 bv = *(const LAS bf16x8*)(gp + t * 16 * (STR * 2) + ks * 64);
            m.c[t] = __builtin_amdgcn_mfma_f32_16x16x32_bf16(av, bv, m.c[t], 0, 0, 0); }
    }
}
template <class F> __device__ __forceinline__ void mm_out(const MM& m, int wave, int lane, F f) {
#pragma unroll
    for (int t = 0; t < 2; ++t) f(16 * (2 * (wave >> 2) + t) + (lane & 15), 16 * (wave & 3) + 4 * (lane >> 4), m.c[t]);
}
__device__ __forceinline__ void st_bf4(LAS unsigned char* arr, int x, int y0, const f32x4& v) { *(LAS u32x2*)(arr + x * (STR * 2) + y0 * 2) = (u32x2){pk2(v[0], v[1]), pk2(v[2], v[3])}; }
__device__ __forceinline__ f32x4 ld_bf4(const LAS unsigned char* arr, int x, int y0) { const u32x2 w = *(const LAS u32x2*)(arr + x * (STR * 2) + y0 * 2); return (f32x4){bf_lo(w.x), bf_hi(w.x), bf_lo(w.y), bf_hi(w.y)}; }

struct P { const bf16_t* PROJ; const float *mu, *w0, *a0, *k_k, *k_a, *r_k, *ln_g, *ln_b; const bf16_t *W2T, *A2T, *G2T; bf16_t *MS, *GS; bf16_t* OA; unsigned char* ws; };
__device__ __forceinline__ bf16_t* hs_ptr(unsigned char* ws, int u) { return (bf16_t*)(ws + (u < 8 ? (size_t)(88 + u) * MiB : (size_t)(240 + u - 8) * MiB)); }

template <int PH>
__device__ __forceinline__ void chunk_unit(const P& p, int u, int c, LAS unsigned char* lds, int tid) {
    asm volatile("" : "+v"(tid));
    const int lane = tid & 63, wave = __builtin_amdgcn_readfirstlane(tid >> 6);
    const int b = u / 12, h = u % 12, hc = h * 64;
#define SL(n) (lds + (n) * SLOT)
    LAS unsigned char *AT = SL(0), *BT = SL(1), *KT = SL(2), *RT = SL(3), *ATt = SL(4), *VTt = SL(5), *BTt = SL(6), *GTb = SL(6), *KTt = SL(7), *SG0 = SL(7);
    LAS unsigned char *AAK = SL(8), *ARB = SL(9), *ARK = SL(10), *AABt = SL(11), *Dm = SL(12), *Dt = SL(13), *Nm = SL(14), *TT = SL(14), *SG1 = SL(14);
    LAS unsigned char *Nt = SL(0), *N2 = SL(1), *N2t = SL(2), *X1t = SL(0), *Wt = SL(1), *U0t = SL(2), *QH = SL(11), *Ht = SL(12);
    LAS unsigned char *TW = SL(12), *AL = SL(13);
    LAS float* WD = (LAS float*)SL(8); LAS float* AD = (LAS float*)(SL(8) + 17408);
    LAS float* Yf = (LAS float*)SL(13);
    LAS float* DG = (LAS float*)(lds + OFF_DG);
    LAS float* GSm = (LAS float*)(lds + OFF_GS);
    LAS float* PCv = (LAS float*)(lds + OFF_PC); LAS float* BON = (LAS float*)(lds + OFF_BON);
    const int tl0 = 8 * wave;
    const size_t grow0 = (size_t)b * SEQ + c * 64 + tl0;
    const bool hasprev = (c * 64 + tl0) > 0;
    float xr[8], xk[8], xv[8];
    {
        auto ldcol = [&](int col, float (&xs)[8]) {
            const bf16_t* pp = p.PROJ + grow0 * RWKV_N + col; const float m = p.mu[col];
            float prev = hasprev ? bf2f(*(pp - RWKV_N)) : 0.f;
#pragma unroll
            for (int tt = 0; tt < 8; ++tt) { const float cur = bf2f(pp[(size_t)tt * RWKV_N]); xs[tt] = cur + (prev - cur) * m; prev = cur; }
        };
        ldcol(hc + lane, xr); ldcol(768 + hc + lane, xk); ldcol(1536 + hc + lane, xv);
        float xs[8];
        ldcol(2304 + lane, xs);
#pragma unroll
        for (int tt = 0; tt < 8; ++tt) *(LAS bf16_t*)(TW + (tl0 + tt) * (STR * 2) + lane * 2) = (bf16_t)f2bf(tanhf(xs[tt]));
        ldcol(2368 + lane, xs);
#pragma unroll
        for (int tt = 0; tt < 8; ++tt) *(LAS bf16_t*)(AL + (tl0 + tt) * (STR * 2) + lane * 2) = (bf16_t)f2bf(xs[tt]);
        if (PH == 1) {
            ldcol(2432 + lane, xs);
#pragma unroll
            for (int tt = 0; tt < 8; ++tt) *(LAS bf16_t*)(SG0 + (tl0 + tt) * (STR * 2) + lane * 2) = (bf16_t)f2bf(sigmoidf_(xs[tt]));
            ldcol(2496 + lane, xs);
#pragma unroll
            for (int tt = 0; tt < 8; ++tt) *(LAS bf16_t*)(SG1 + (tl0 + tt) * (STR * 2) + lane * 2) = (bf16_t)f2bf(sigmoidf_(xs[tt]));
        }
    }
    __syncthreads();
    {
        MM m; mm_zero(m); mm_acc_gl(m, TW, p.W2T + (size_t)hc * 64, 64, wave, lane);
        mm_out(m, wave, lane, [&](int x, int y0, const f32x4& v) { *(LAS f32x4*)(WD + x * 68 + y0) = v; });
        mm_zero(m); mm_acc_gl(m, AL, p.A2T + (size_t)hc * 64, 64, wave, lane);
        mm_out(m, wave, lane, [&](int x, int y0, const f32x4& v) { *(LAS f32x4*)(AD + x * 68 + y0) = v; });
    }
    MM mg; mm_zero(mg);
    if (PH == 1) { mm_acc_gl(mg, SG0, p.G2T + (size_t)hc * 128, 128, wave, lane); mm_acc_gl(mg, SG1, p.G2T + (size_t)hc * 128 + 64, 128, wave, lane); }
    __syncthreads();
    if (PH == 1) { mm_out(mg, wave, lane, [&](int x, int y0, const f32x4& v) { st_bf4(GTb, x, y0, v); }); }
    {
        const int j = lane; const float w0 = p.w0[hc + j], a0 = p.a0[hc + j], kkc = p.k_k[hc + j], kac = p.k_a[hc + j];
        float ldv[8], alr[8], kk[8], kp[8];
        float cs = 0.f;
#pragma unroll
        for (int tt = 0; tt < 8; ++tt) { const int t = tl0 + tt;
            const float wd = w0 + WD[t * 68 + j]; const float sp = __logf(1.0f + __expf(-wd)); const float w = -sp - 0.5f;
            const float l = -__expf(w); cs += l; ldv[tt] = cs;
            const float a = sigmoidf_(a0 + AD[t * 68 + j]); alr[tt] = a;
            const float kr = xk[tt] * kkc; const float ss = wave_sum(kr * kr); kk[tt] = kr * rsqrtf(fmaxf(ss, 1e-24f));
            kp[tt] = xk[tt] * (1.0f + (a - 1.0f) * kac);
            if (PH == 1) { const float bs = wave_sum(xr[tt] * kp[tt] * p.r_k[hc + j]); if (lane == 0) BON[t] = bs; }
        }
        GSm[wave * 64 + j] = cs;
        __syncthreads();
        float pre = 0.f, tot = 0.f;
#pragma unroll
        for (int w2 = 0; w2 < 8; ++w2) { const float g = GSm[w2 * 64 + j]; tot += g; if (w2 < wave) pre += g; }
        const float pc = __expf(tot);
        if (wave == 0) PCv[j] = pc;
        u32x4 wa, wb, wk, wv;
        float ea[8], eb[8], ek[8];
#pragma unroll
        for (int tt = 0; tt < 8; ++tt) { const int t = tl0 + tt;
            const float lp = pre + ldv[tt]; const float lprev = lp - (ldv[tt] - (tt ? ldv[tt - 1] : 0.f));
            const float einv = __expf(-lp);
            const float at = -kk[tt] * __expf(lprev), bt = kk[tt] * alr[tt] * einv, kt = kp[tt] * einv;
            ea[tt] = at; eb[tt] = bt; ek[tt] = kt;
            *(LAS bf16_t*)(AT + t * (STR * 2) + j * 2) = (bf16_t)f2bf(at);
            *(LAS bf16_t*)(BT + t * (STR * 2) + j * 2) = (bf16_t)f2bf(bt);
            *(LAS bf16_t*)(KT + t * (STR * 2) + j * 2) = (bf16_t)f2bf(kt);
            if (PH == 1) *(LAS bf16_t*)(RT + t * (STR * 2) + j * 2) = (bf16_t)f2bf(xr[tt] * __expf(lp));
        }
        wa = (u32x4){pk2(ea[0], ea[1]), pk2(ea[2], ea[3]), pk2(ea[4], ea[5]), pk2(ea[6], ea[7])};
        wv = (u32x4){pk2(xv[0], xv[1]), pk2(xv[2], xv[3]), pk2(xv[4], xv[5]), pk2(xv[6], xv[7])};
        *(LAS u32x4*)(ATt + j * (STR * 2) + tl0 * 2) = wa;
        *(LAS u32x4*)(VTt + j * (STR * 2) + tl0 * 2) = wv;
        if (PH == 0) {
            wb = (u32x4){pk2(eb[0], eb[1]), pk2(eb[2], eb[3]), pk2(eb[4], eb[5]), pk2(eb[6], eb[7])};
            wk = (u32x4){pk2(ek[0], ek[1]), pk2(ek[2], ek[3]), pk2(ek[4], ek[5]), pk2(ek[6], ek[7])};
            *(LAS u32x4*)(BTt + j * (STR * 2) + tl0 * 2) = wb;
            *(LAS u32x4*)(KTt + j * (STR * 2) + tl0 * 2) = wk;
        }
    }
    __syncthreads();
    {
        { LAS u32x4* z = (LAS u32x4*)Dm; for (int i = tid; i < 2 * SLOT / 16; i += NTHREADS) z[i] = (u32x4){0u, 0u, 0u, 0u}; }
        MM m; mm_zero(m); mm_acc(m, AT, BT, wave, lane);
        mm_out(m, wave, lane, [&](int x, int y0, const f32x4& v) { if ((x >> 4) == (y0 >> 4)) {
#pragma unroll
            for (int e = 0; e < 4; ++e) DG[(x >> 4) * 272 + (x & 15) * 17 + (y0 & 15) + e] = (y0 + e < x) ? v[e] : 0.f; } });
        mm_zero(m); mm_acc(m, BT, AT, wave, lane);
        mm_out(m, wave, lane, [&](int x, int y0, const f32x4& v) { const f32x4 o = ((y0 >> 4) > (x >> 4)) ? v : (f32x4){0.f, 0.f, 0.f, 0.f}; st_bf4(AABt, x, y0, o); });
        mm_zero(m); mm_acc(m, AT, KT, wave, lane);
        mm_out(m, wave, lane, [&](int x, int y0, const f32x4& v) { f32x4 o;
#pragma unroll
            for (int e = 0; e < 4; ++e) o[e] = (y0 + e < x) ? v[e] : 0.f;
            st_bf4(AAK, x, y0, o); });
        if (PH == 1) {
            mm_zero(m); mm_acc(m, RT, BT, wave, lane);
            mm_out(m, wave, lane, [&](int x, int y0, const f32x4& v) { f32x4 o;
#pragma unroll
                for (int e = 0; e < 4; ++e) o[e] = (y0 + e <= x) ? v[e] : 0.f;
                st_bf4(ARB, x, y0, o); });
            mm_zero(m); mm_acc(m, RT, KT, wave, lane);
            mm_out(m, wave, lane, [&](int x, int y0, const f32x4& v) { f32x4 o;
#pragma unroll
                for (int e = 0; e < 4; ++e) o[e] = (y0 + e <= x) ? v[e] : 0.f;
                st_bf4(ARK, x, y0, o); });
        }
    }
    __syncthreads();
    if (wave < 4 && lane < 16) {
        const LAS float* Ab = DG + wave * 272; float Tr[16];
#pragma unroll
        for (int t = 0; t < 16; ++t) { float acc = (t == lane) ? 1.f : 0.f;
#pragma unroll
            for (int s = 0; s < t; ++s) acc += Ab[t * 17 + s] * Tr[s];
            Tr[t] = acc; }
        const int r0 = 16 * wave;
#pragma unroll
        for (int t = 0; t < 16; ++t) *(LAS bf16_t*)(Dm + (r0 + t) * (STR * 2) + (r0 + lane) * 2) = (bf16_t)f2bf(Tr[t]);
        *(LAS u32x4*)(Dt + (r0 + lane) * (STR * 2) + r0 * 2) = (u32x4){pk2(Tr[0], Tr[1]), pk2(Tr[2], Tr[3]), pk2(Tr[4], Tr[5]), pk2(Tr[6], Tr[7])};
        *(LAS u32x4*)(Dt + (r0 + lane) * (STR * 2) + r0 * 2 + 16) = (u32x4){pk2(Tr[8], Tr[9]), pk2(Tr[10], Tr[11]), pk2(Tr[12], Tr[13]), pk2(Tr[14], Tr[15])};
    }
    __syncthreads();
    {
        MM m; mm_zero(m); mm_acc(m, Dm, AABt, wave, lane); mm_out(m, wave, lane, [&](int x, int y0, const f32x4& v) { st_bf4(Nm, x, y0, v); });
        mm_zero(m); mm_acc(m, AABt, Dm, wave, lane); mm_out(m, wave, lane, [&](int x, int y0, const f32x4& v) { st_bf4(Nt, x, y0, v); });
    }
    __syncthreads();
    {
        MM m; mm_zero(m); mm_acc(m, Nm, Nt, wave, lane); mm_out(m, wave, lane, [&](int x, int y0, const f32x4& v) { st_bf4(N2, x, y0, v); });
        mm_zero(m); mm_acc(m, Nt, Nm, wave, lane); mm_out(m, wave, lane, [&](int x, int y0, const f32x4& v) { st_bf4(N2t, x, y0, v); });
    }
    __syncthreads();
    {
        MM m; mm_zero(m); mm_acc(m, Nm, N2t, wave, lane);
        mm_out(m, wave, lane, [&](int x, int y0, const f32x4& v) { f32x4 o = v + ld_bf4(Nm, x, y0) + ld_bf4(N2, x, y0);
#pragma unroll
            for (int e = 0; e < 4; ++e) if (y0 + e == x) o[e] += 1.0f;
            st_bf4(N2, x, y0, o); });
    }
    __syncthreads();
    {
        MM m; mm_zero(m); mm_acc(m, N2, Dt, wave, lane); mm_out(m, wave, lane, [&](int x, int y0, const f32x4& v) { st_bf4(TT, x, y0, v); });
    }
    __syncthreads();
    {
        MM m; mm_zero(m); mm_acc(m, VTt, AAK, wave, lane); mm_out(m, wave, lane, [&](int x, int y0, const f32x4& v) { st_bf4(X1t, x, y0, v); });
        mm_zero(m); mm_acc(m, ATt, TT, wave, lane); mm_out(m, wave, lane, [&](int x, int y0, const f32x4& v) { st_bf4(Wt, x, y0, v); });
        if (PH == 1) {
            const bf16_t* hp = hs_ptr(p.ws, u) + (size_t)c * 4096; const int row = tid >> 3, ch = tid & 7;
            *(LAS u32x4*)(Ht + row * (STR * 2) + ch * 16) = *(const u32x4*)(hp + row * 64 + ch * 8);
        }
    }
    __syncthreads();
    { MM m; mm_zero(m); mm_acc(m, X1t, TT, wave, lane); mm_out(m, wave, lane, [&](int x, int y0, const f32x4& v) { st_bf4(U0t, x, y0, v); }); }
    __syncthreads();
    if (PH == 0) {
        bf16_t* Mo = p.MS + ((size_t)u * 128 + c) * 4096; bf16_t* Go = p.GS + ((size_t)u * 128 + c) * 4096;
        MM m; mm_zero(m); mm_acc(m, BTt, Wt, wave, lane);
        mm_out(m, wave, lane, [&](int x, int y0, const f32x4& v) { const float pc = PCv[x]; f32x4 o = v;
#pragma unroll
            for (int e = 0; e < 4; ++e) { if (y0 + e == x) o[e] += 1.0f; o[e] *= pc; }
            *(u32x2*)(Mo + x * 64 + y0) = (u32x2){pk2(o[0], o[1]), pk2(o[2], o[3])}; });
        mm_zero(m); mm_acc(m, U0t, BTt, wave, lane); mm_acc(m, VTt, KTt, wave, lane);
        mm_out(m, wave, lane, [&](int x, int y0, const f32x4& v) { const f32x4 pc = *(const LAS f32x4*)(PCv + y0); const f32x4 o = v * pc;
            *(u32x2*)(Go + x * 64 + y0) = (u32x2){pk2(o[0], o[1]), pk2(o[2], o[3])}; });
    } else {
        { MM m; mm_zero(m); mm_acc(m, ARB, Wt, wave, lane); mm_out(m, wave, lane, [&](int x, int y0, const f32x4& v) { const f32x4 o = v + ld_bf4(RT, x, y0); st_bf4(QH, x, y0, o); }); }
        __syncthreads();
        { MM m; mm_zero(m); mm_acc(m, QH, Ht, wave, lane); mm_acc(m, ARB, U0t, wave, lane); mm_acc(m, ARK, VTt, wave, lane);
          __syncthreads();
          mm_out(m, wave, lane, [&](int x, int y0, const f32x4& v) { *(LAS f32x4*)(Yf + x * 68 + y0) = v; }); }
        __syncthreads();
        { const int i = lane; const float lg = p.ln_g[hc + i], lb = p.ln_b[hc + i];
#pragma unroll
          for (int tt = 0; tt < 8; ++tt) { const int t = tl0 + tt;
              const float y = Yf[t * 68 + i]; const float mean = wave_sum(y) * (1.f / 64.f); const float d = y - mean; const float var = wave_sum(d * d) * (1.f / 64.f);
              const float yn = d * rsqrtf(var + 64e-5f) * lg + lb;
              const float g = bf2f(*(const LAS bf16_t*)(GTb + t * (STR * 2) + i * 2));
              const float o = (yn + BON[t] * xv[tt]) * g;
              p.OA[(grow0 + tt) * 1024 + hc + i] = (bf16_t)f2bf(o); } }
    }
    __syncthreads();
#undef SL
}

__device__ __forceinline__ void scan_unit(const P& p, int u, int tid) {
    asm volatile("" : "+v"(tid));
    const int lane = tid & 63, v = tid >> 6, l15 = lane & 15, q = lane >> 4, i = 16 * v + l15;
    if (v >= 4) return;
    const bf16_t* Mp = p.MS + (size_t)u * 128 * 4096; const bf16_t* Gp = p.GS + (size_t)u * 128 * 4096; bf16_t* Hp = hs_ptr(p.ws, u);
    f32x4 Hacc[4];
#pragma unroll
    for (int jt = 0; jt < 4; ++jt) Hacc[jt] = (f32x4){0.f, 0.f, 0.f, 0.f};
    u32x2 mA[4][2][2], gC[4];
#define RK_LOADMG(cc) do { const bf16_t* mp_ = Mp + (size_t)(cc) * 4096; const bf16_t* gp_ = Gp + (size_t)(cc) * 4096; \
        _Pragma("unroll") for (int jt = 0; jt < 4; ++jt) { _Pragma("unroll") for (int ks = 0; ks < 2; ++ks) { \
            mA[jt][ks][0] = *(const u32x2*)(mp_ + (16 * jt + l15) * 64 + 32 * ks + 4 * q); mA[jt][ks][1] = *(const u32x2*)(mp_ + (16 * jt + l15) * 64 + 32 * ks + 16 + 4 * q); } \
            gC[jt] = *(const u32x2*)(gp_ + i * 64 + 16 * jt + 4 * q); } } while (0)
    RK_LOADMG(0);
    for (int c = 0; c < 128; ++c) {
#pragma unroll
        for (int jt = 0; jt < 4; ++jt) *(u32x2*)(Hp + (size_t)c * 4096 + i * 64 + 16 * jt + 4 * q) = (u32x2){pk2(Hacc[jt][0], Hacc[jt][1]), pk2(Hacc[jt][2], Hacc[jt][3])};
        if (c == 127) break;
        bf16x8 bfr[2];
#pragma unroll
        for (int ks = 0; ks < 2; ++ks) bfr[ks] = __builtin_bit_cast(bf16x8, (u32x4){pk2(Hacc[2 * ks][0], Hacc[2 * ks][1]), pk2(Hacc[2 * ks][2], Hacc[2 * ks][3]), pk2(Hacc[2 * ks + 1][0], Hacc[2 * ks + 1][1]), pk2(Hacc[2 * ks + 1][2], Hacc[2 * ks + 1][3])});
        bf16x8 afr[4][2];
#pragma unroll
        for (int jt = 0; jt < 4; ++jt) {
#pragma unroll
            for (int ks = 0; ks < 2; ++ks) afr[jt][ks] = __builtin_bit_cast(bf16x8, (u32x4){mA[jt][ks][0].x, mA[jt][ks][0].y, mA[jt][ks][1].x, mA[jt][ks][1].y});
            Hacc[jt] = (f32x4){bf_lo(gC[jt].x), bf_hi(gC[jt].x), bf_lo(gC[jt].y), bf_hi(gC[jt].y)}; }
        if (c + 1 < 127) RK_LOADMG(c + 1);
#pragma unroll
        for (int jt = 0; jt < 4; ++jt)
#pragma unroll
            for (int ks = 0; ks < 2; ++ks) Hacc[jt] = __builtin_amdgcn_mfma_f32_16x16x32_bf16(afr[jt][ks], bfr[ks], Hacc[jt], 0, 0, 0);
    }
#undef RK_LOADMG
}
}

#define XB_TMO      128
#define XB_XCNT(j)  (256  + 64 * (j))
#define XB_XSUB(j)  (1280 + 64 * (j))
#define XB_XGEN(j)  (2304 + 64 * (j))
#define XB_TOP      3328
#define XB_TOPGEN   3392
#define XCD_BAR_WORDS 3456
#define XB_SPIN_CAP (1u << 18)
__device__ __forceinline__ unsigned xb_ld(unsigned* p)              { return __hip_atomic_load(p, __ATOMIC_RELAXED, __HIP_MEMORY_SCOPE_AGENT); }
__device__ __forceinline__ unsigned xb_add(unsigned* p, unsigned v) { return __hip_atomic_fetch_add(p, v, __ATOMIC_RELAXED, __HIP_MEMORY_SCOPE_AGENT); }
__device__ __forceinline__ unsigned xb_xcc_id() { return (unsigned)__builtin_amdgcn_s_getreg((3 << 11) | 20) & 0xFu; }
#define XB_SPIN(cond, bar) do { unsigned _sp = 0; while (cond) { __builtin_amdgcn_s_sleep(1); \
    if ((++_sp & 255u) == 0u) { if (xb_ld(&(bar)[XB_TMO])) break; if (_sp > XB_SPIN_CAP) { atomicAdd(&(bar)[XB_TMO], 1u); break; } } } } while (0)
struct XcdBarrier { unsigned* bar; unsigned x; volatile LAS unsigned* st; };
__device__ __forceinline__ XcdBarrier xcd_barrier_post(unsigned* bar, volatile LAS unsigned* st) {
    XcdBarrier b; b.bar = bar; b.x = xb_xcc_id(); b.st = st;
    if (threadIdx.x == 0) (void)xb_add(&bar[XB_XCNT(b.x)], 1u);
    return b;
}
__device__ __forceinline__ void xcd_barrier_complete(unsigned* bar, unsigned x, unsigned& nloc, unsigned& nx) {
    const unsigned G = gridDim.x * gridDim.y * gridDim.z;
    unsigned sum, cnt, mine, sp = 0u;
    for (;;) {
        sum = 0u; cnt = 0u; mine = 0u;
#pragma unroll
        for (unsigned j = 0; j < 16; ++j) { const unsigned c = xb_ld(&bar[XB_XCNT(j)]); sum += c; cnt += (c > 0u) ? 1u : 0u; mine = (j == x) ? c : mine; }
        if (sum == G) break;
        __builtin_amdgcn_s_sleep(1);
        if ((++sp & 255u) == 0u) { if (xb_ld(&bar[XB_TMO])) break; if (sp > XB_SPIN_CAP) { atomicAdd(&bar[XB_TMO], 1u); break; } }
    }
    nloc = mine > 0u ? mine : 1u; nx = cnt > 0u ? cnt : 1u;
}
__device__ __forceinline__ void xcd_barrier(const XcdBarrier& b) {
    asm volatile("s_waitcnt vmcnt(0)" ::: "memory");
    __syncthreads();
    if (threadIdx.x == 0) {
        unsigned* bar = b.bar;
        __builtin_amdgcn_s_waitcnt(0);
        unsigned nloc = b.st[0], nx = b.st[1];
        if (nloc == 0u) { xcd_barrier_complete(bar, b.x, nloc, nx); b.st[0] = nloc; b.st[1] = nx; }
        const unsigned old = xb_add(&bar[XB_XSUB(b.x)], 1u);
        const unsigned gen = old / nloc;
        if (old + 1u == (gen + 1u) * nloc) {
            __builtin_amdgcn_fence(__ATOMIC_RELEASE, "agent");
            asm volatile("s_waitcnt vmcnt(0)" ::: "memory");
            const unsigned og = xb_add(&bar[XB_TOP], 1u);
            const unsigned tg = og / nx;
            if (og + 1u == (tg + 1u) * nx) xb_add(&bar[XB_TOPGEN], 1u);
            else XB_SPIN(xb_ld(&bar[XB_TOPGEN]) == tg, bar);
            __builtin_amdgcn_fence(__ATOMIC_ACQUIRE, "agent");
            xb_add(&bar[XB_XGEN(b.x)], 1u);
            asm volatile("s_waitcnt vmcnt(0)" ::: "memory");
        } else {
            XB_SPIN(xb_ld(&bar[XB_XGEN(b.x)]) == gen, bar);
            __builtin_amdgcn_fence(__ATOMIC_ACQUIRE, "agent");
            asm volatile("s_waitcnt vmcnt(0)" ::: "memory");
        }
    }
    __syncthreads();
}

__global__ void __launch_bounds__(NTHREADS, 2) fwd_kernel(Args a) {
    extern __shared__ __attribute__((aligned(16))) unsigned char lds_raw[];
    LAS unsigned char* lds = (LAS unsigned char*)lds_raw;
    cg::grid_group grid = cg::this_grid();
    const int G = gridDim.x, bid = blockIdx.x, NGW = G * NWAVES, NGT = G * NTHREADS;
#define TID ({ int t_ = threadIdx.x; asm volatile("" : "+v"(t_)); t_; })
#define tid TID
#define lane (TID & 63)
#define wave (__builtin_amdgcn_readfirstlane(TID >> 6))
#define gw (bid * NWAVES + wave)
#define gtid (bid * NTHREADS + TID)
#define IN(i) (a.in[i])
#define WSP(T, off) ((T*)(a.ws + (off)))
#define XIN IN(0)
#define MEMIN IN(1)
#define positions ((const int*)IN(2))
#define mem_norm_g IN(3)
#define w_mem_kv IN(4)
#define pre_mix_g IN(5)
#define post_mix_g IN(6)
#define pre_ffn_g IN(7)
#define post_ffn_g IN(8)
#define w_out IN(9)
#define w_ffn_in IN(10)
#define w_ffn_out IN(11)
#define nsa_w_in IN(12)
#define nsa_gate_b IN(13)
#define cmp_pos_k IN(14)
#define cmp_pos_v IN(15)
#define cmp_k_w1 IN(16)
#define cmp_k_w2 IN(17)
#define cmp_v_w1 IN(18)
#define cmp_v_w2 IN(19)
#define rwkv_w_in IN(20)
#define OUTP (a.out)
#define WT_NSA WSP(bf16_t, WS_WT_NSA)
#define WT_RWKV WSP(bf16_t, WS_WT_RWKV)
#define WT_OUT WSP(bf16_t, WS_WT_OUT)
#define WT_FIN WSP(bf16_t, WS_WT_FIN)
#define WT_FOUT WSP(bf16_t, WS_WT_FOUT)
#define WT_C1K WSP(bf16_t, WS_WT_C1K)
#define WT_C1V WSP(bf16_t, WS_WT_C1V)
#define WT_MKV WSP(bf16_t, WS_WT_MKV)
#define MEMN WSP(bf16_t, WS_MEMN)
#define MKV WSP(bf16_t, WS_MKV)
#define COS WSP(float, WS_COS)
#define SIN WSP(float, WS_SIN)
#define KC WSP(bf16_t, WS_KC)
#define VC WSP(bf16_t, WS_VC)
#define BIASK WSP(float, WS_BIASK)
#define BIASV WSP(float, WS_BIASV)
#define GATES WSP(float, WS_GATES)
#define CMPHK WSP(bf16_t, WS_CMPHK)
#define CMPHV WSP(bf16_t, WS_CMPHV)
#define HN_A WSP(bf16_t, WS_HN_A)
#define HN_B WSP(bf16_t, WS_HN_B)
#define OA WSP(bf16_t, WS_OA)
#define FF WSP(float, WS_FF)
#define Qb WSP(bf16_t, WS_Q)
#define KV6 WSP(bf16_t, WS_KV6)
#define QM WSP(bf16_t, WS_QM)
#define ACT WSP(bf16_t, WS_ACT)
#define PROJ1 WSP(bf16_t, WS_PROJ1)
#define MVT WSP(bf16_t, WS_MVT)
#define W2T WSP(bf16_t, WS_W2T)
#define A2T WSP(bf16_t, WS_A2T)
#define G2T WSP(bf16_t, WS_G2T)
#define RKM WSP(bf16_t, WS_RKM)
#define RKG WSP(bf16_t, WS_RKG)

    {
        LAS float* scr = (LAS float*)(lds + wave * 16384);
        const int I_NSA = (DM / 64) * ((NSA_N + 31) / 32), I_RWKV = (DM / 64) * (RWKV_N / 32), I_OUT = (DM / 64) * (DM / 32), I_FIN = (DM / 64) * (FFN_N2 / 32), I_FOUT = (FFN_H / 64) * (DM / 32);
        const int I_C1 = (2048 / 64) * (256 / 32), I_MKV = (DM / 64) * (512 / 32);
        const int NIT = I_NSA + I_RWKV + 2 * I_OUT + 2 * I_FIN + 2 * I_FOUT + 2 * I_C1 + I_MKV + 24 + 24 + 48;
        for (int it = gw; it < NIT; it += NGW) {
            int r = it;
            if (r < I_NSA) { transpose_item(nsa_w_in, DM, NSA_N, WT_NSA, MapNsa(), scr, r, lane); continue; } r -= I_NSA;
            if (r < I_RWKV) { transpose_item(rwkv_w_in, DM, RWKV_N, WT_RWKV, MapId(), scr, r, lane); continue; } r -= I_RWKV;
            if (r < 2 * I_OUT) { const int l = r / I_OUT; transpose_item(w_out + (size_t)l * DM * DM, DM, DM, WT_OUT + (size_t)l * DM * DM, MapId(), scr, r % I_OUT, lane); continue; } r -= 2 * I_OUT;
            if (r < 2 * I_FIN) { const int l = r / I_FIN; transpose_item(w_ffn_in + (size_t)l * DM * FFN_N2, DM, FFN_N2, WT_FIN + (size_t)l * DM * FFN_N2, MapFfn(), scr, r % I_FIN, lane); continue; } r -= 2 * I_FIN;
            if (r < 2 * I_FOUT) { const int l = r / I_FOUT; transpose_item(w_ffn_out + (size_t)l * FFN_H * DM, FFN_H, DM, WT_FOUT + (size_t)l * FFN_H * DM, MapId(), scr, r % I_FOUT, lane); continue; } r -= 2 * I_FOUT;
            if (r < I_C1) { transpose_item(cmp_k_w1, 2048, 256, WT_C1K, MapId(), scr, r, lane); continue; } r -= I_C1;
            if (r < I_C1) { transpose_item(cmp_v_w1, 2048, 256, WT_C1V, MapId(), scr, r, lane); continue; } r -= I_C1;
            if (r < I_MKV) { transpose_item(w_mem_kv, DM, 512, WT_MKV, MapId(), scr, r, lane); continue; } r -= I_MKV;
            if (r < 24) { transpose_item(a.in[23], 64, PRIM, W2T, MapId(), scr, r, lane); continue; } r -= 24;
            if (r < 24) { transpose_item(a.in[25], 64, PRIM, A2T, MapId(), scr, r, lane); continue; } r -= 24;
            transpose_item(a.in[26], 128, PRIM, G2T, MapId(), scr, r, lane);
        }
        if (gtid == 0) *(unsigned*)a.ws = 0u;
        if (bid == 0) for (int i = tid; i < XCD_BAR_WORDS; i += NTHREADS) ((unsigned*)(a.ws + 4096))[i] = 0u;
        if (tid < 4) ((LAS unsigned*)(lds + LDS_BYTES - 16))[tid] = 0u;
        for (int i = gtid; i < (NSA_NP - NSA_N) * DM / 8; i += NGT) ((u32x4*)(WT_NSA + (size_t)NSA_N * DM))[i] = (u32x4){0u, 0u, 0u, 0u};
        for (int i = gtid; i < MTOK * 8; i += NGT) { const int row = i >> 3, k = i & 7;
            const float inv = (k == 0) ? 1.0f : (k == 1) ? 0.1939227432012558f : (k == 2) ? 0.03760603070259094f : (k == 3) ? 0.007292664609849453f : (k == 4) ? 0.0014142135623842478f : (k == 5) ? 0.00027424818836152554f : (k == 6) ? 5.318296098266728e-05f : 1.0313386155758053e-05f;
            const float ang = (float)positions[row] * inv; COS[i] = cosf(ang); SIN[i] = sinf(ang); }
        if (gtid < 512) { const int hh = gtid & 255; const float* pos = gtid < 256 ? cmp_pos_k : cmp_pos_v; const float* w1 = gtid < 256 ? cmp_k_w1 : cmp_v_w1; float s = 0.f;
            for (int k = 0; k < 2048; ++k) s += pos[k] * w1[(size_t)k * 256 + hh];
            (gtid < 256 ? BIASK : BIASV)[hh] = s; }
        for (int m = gw; m < MTOK; m += NGW) rms_row_to_bf16(XIN + (size_t)m * DM, pre_mix_g, HN_A + (size_t)m * DM, lane);
        for (int m = gw; m < BATCH * NMEM; m += NGW) rms_row_to_bf16(MEMIN + (size_t)m * DM, mem_norm_g, MEMN + (size_t)m * DM, lane);
    }
    grid.sync();
    const XcdBarrier xbar = xcd_barrier_post((unsigned*)(a.ws + 4096), (volatile LAS unsigned*)(lds + LDS_BYTES - 16));

    {
        { pg8::Gemm g{MEMN, WT_MKV, BATCH * NMEM, 512, DM, DM}; pg8::StaticOrder S; S.init(g.M, g.N, G, bid); pg8::EpiBf16 E{MKV, 512};
          pg8::gemm_phase<pg8::EpiBf16, true>(lds, g, S, E); }
        { pg8::Gemm g{HN_A, WT_NSA, MTOK, NSA_NP, DM, DM}; pg8::StaticOrder S; S.init(g.M, g.N, G, bid); pg8::EpiNsaSplit E{Qb, KV6, QM, GATES, nsa_gate_b};
          pg8::gemm_phase<pg8::EpiNsaSplit, true>(lds, g, S, E); }
    }
    xcd_barrier(xbar);

    {
        { pg8::Gemm g{KV6, WT_C1K, 3072, 256, 2048, 1024}; pg8::StaticOrder S; S.init(g.M, g.N, G, bid); pg8::EpiGeluBias E{CMPHK, 256, BIASK};
          pg8::gemm_phase<pg8::EpiGeluBias, true>(lds, g, S, E); }
        { pg8::Gemm g{KV6 + KV6_STRIDE, WT_C1V, 3072, 256, 2048, 1024}; pg8::StaticOrder S; S.init(g.M, g.N, G, bid); pg8::EpiGeluBias E{CMPHV, 256, BIASV};
          pg8::gemm_phase<pg8::EpiGeluBias, true>(lds, g, S, E); }
        for (int i = gtid; i < BATCH * 256 * 256; i += NGT) { const int m = i & 255, c = (i >> 8) & 255, b = i >> 16; MVT[i] = MKV[((size_t)b * 256 + m) * 512 + 256 + c]; }
        for (int i = gtid; i < MTOK * 18 * 8; i += NGT) { const int k = i & 7, slot = (i >> 3) % 18, row = i / 144;
            bf16_t* p;
            if (slot < 12) p = Qb + (size_t)row * 768 + slot * 64;
            else { const int s2 = slot - 12, which = s2 / 3, gg = s2 % 3, b = row >> 13, s = row & 8191; p = KV6 + (size_t)(which == 0 ? 2 : 4) * KV6_STRIDE + ((size_t)(b * 3 + gg) * SEQ + s) * HD; }
            const float c = COS[row * 8 + k], sn = SIN[row * 8 + k]; const float t1 = bf2f(p[k]), t2 = bf2f(p[8 + k]);
            p[k] = (bf16_t)f2bf(t1 * c - t2 * sn); p[8 + k] = (bf16_t)f2bf(t1 * sn + t2 * c); }
    }
    xcd_barrier(xbar);

    {
        for (int it = gw; it < 2 * 3072; it += NGW) { const int kv = it / 3072, m = it % 3072, n = m & 511, bgi = m >> 9, b = bgi / 3;
            const bf16_t* hrow = (kv ? CMPHV : CMPHK) + (size_t)m * 256; const float* w2 = kv ? cmp_v_w2 : cmp_k_w2;
            float s = 0.f;
            for (int hh = 0; hh < 256; ++hh) s += bf2f(hrow[hh]) * w2[hh * 64 + lane];
            if (kv == 0) { const float other = __shfl(s, lane ^ 8);
                if (lane < 16 && n < 511) { const int prow = b * SEQ + 16 * n + 31; const float c = COS[prow * 8 + (lane & 7)], sn = SIN[prow * 8 + (lane & 7)];
                    s = (lane < 8) ? (s * c - other * sn) : (other * sn + s * c); } }
            if (n >= 511) s = 0.f;
            if (kv) VC[((size_t)bgi * 64 + lane) * 512 + n] = (bf16_t)f2bf(s); else KC[(size_t)m * 64 + lane] = (bf16_t)f2bf(s); }
    }
    xcd_barrier(xbar);

    for (int rep = 0; rep < REP_ATT; ++rep) {
        if (rep) { xcd_barrier(xbar); if (gtid == 0) *(unsigned*)a.ws = 0u; xcd_barrier(xbar); }
        att::NsaP P{Qb, KV6, KC, VC, GATES, OA};
        LAS int* misc = (LAS int*)(lds + att::LDS_MISC);
        for (;;) {
            if (tid == 0) misc[0] = (int)atomicAdd((unsigned*)a.ws, 1u);
            __syncthreads();
            const int u = __builtin_amdgcn_readfirstlane(misc[0]);
            __syncthreads();
            if (u >= 1024) break;
            if (u < 768) { const int blk = 127 - u / 6, bgi = u % 6; att::nsa_unit(P, bgi / 3, bgi % 3, blk, lds, tid); }
            else { const int v = u - 768; att::mem_unit(QM, 256, MKV, MVT, OA, v >> 7, (v >> 2) & 31, v & 3, lds, tid); }
        }
    }
    xcd_barrier(xbar);

#pragma unroll
    for (int layer = 0; layer < 2; ++layer) {
        if (layer == 1) {
            { pg8::Gemm g{HN_B, WT_RWKV, MTOK, RWKV_N, DM, DM}; pg8::StaticOrder S; S.init(g.M, g.N, G, bid); pg8::EpiBf16 E{PROJ1, RWKV_N};
              pg8::gemm_phase<pg8::EpiBf16, true>(lds, g, S, E); }
            xcd_barrier(xbar);
            for (int rep = 0; rep < REP_RWKV; ++rep) {
            if (rep) xcd_barrier(xbar);
            {
                for (int v = bid; v < 256; v += G) att::mem_unit(PROJ1 + 2560, RWKV_N, MKV, MVT, OA, v >> 7, (v >> 2) & 31, v & 3, lds, tid);
                __syncthreads();
                const rk::P RP{PROJ1, a.in[21], a.in[22], a.in[24], a.in[27], a.in[28], a.in[29], a.in[30], a.in[31], W2T, A2T, G2T, RKM, RKG, OA, a.ws};
                for (int it = bid; it < 24 * 128; it += G) rk::chunk_unit<0>(RP, it >> 7, it & 127, lds, tid);
            }
            xcd_barrier(xbar);
            {
                const rk::P RP{PROJ1, a.in[21], a.in[22], a.in[24], a.in[27], a.in[28], a.in[29], a.in[30], a.in[31], W2T, A2T, G2T, RKM, RKG, OA, a.ws};
                if (bid < 24) rk::scan_unit(RP, bid, tid);
            }
            xcd_barrier(xbar);
            {
                const rk::P RP{PROJ1, a.in[21], a.in[22], a.in[24], a.in[27], a.in[28], a.in[29], a.in[30], a.in[31], W2T, A2T, G2T, RKM, RKG, OA, a.ws};
                for (int it = bid; it < 24 * 128; it += G) rk::chunk_unit<1>(RP, it >> 7, it & 127, lds, tid);
            }
            }
            xcd_barrier(xbar);
        }
        float* MIX = (float*)(a.ws + (layer == 0 ? WS_MIX0 : WS_MIX1));
        { pg8::Gemm g{OA, WT_OUT + (size_t)layer * DM * DM, MTOK, DM, DM, DM}; pg8::StaticOrder S; S.init(g.M, g.N, G, bid); pg8::EpiF32 E{MIX, DM};
          pg8::gemm_phase<pg8::EpiF32, true>(lds, g, S, E); }
        xcd_barrier(xbar);
        for (int m = gw; m < MTOK; m += NGW) res_row((layer == 0 ? XIN : OUTP) + (size_t)m * DM, MIX + (size_t)m * DM, post_mix_g + layer * DM, pre_ffn_g + layer * DM, OUTP + (size_t)m * DM, HN_A + (size_t)m * DM, lane);
        xcd_barrier(xbar);
        { pg8::Gemm g{HN_A, WT_FIN + (size_t)layer * DM * FFN_N2, MTOK, FFN_N2, DM, DM}; pg8::StaticOrder S; S.init(g.M, g.N, G, bid); pg8::EpiSwiglu E{ACT, FFN_H};
          pg8::gemm_phase<pg8::EpiSwiglu, true>(lds, g, S, E); }
        xcd_barrier(xbar);
        { pg8::Gemm g{ACT, WT_FOUT + (size_t)layer * FFN_H * DM, MTOK, DM, FFN_H, FFN_H}; pg8::StaticOrder S; S.init(g.M, g.N, G, bid); pg8::EpiF32 E{FF, DM};
          pg8::gemm_phase<pg8::EpiF32, true>(lds, g, S, E); }
        xcd_barrier(xbar);
        for (int m = gw; m < MTOK; m += NGW) res_row(OUTP + (size_t)m * DM, FF + (size_t)m * DM, post_ffn_g + layer * DM, layer == 0 ? pre_mix_g + DM : nullptr, OUTP + (size_t)m * DM, layer == 0 ? HN_B + (size_t)m * DM : nullptr, lane);
        if (layer == 0) xcd_barrier(xbar);
    }
}

#undef tid
#undef lane
#undef wave
#undef gw
#undef gtid
extern "C" void kernel_launch(void* const* d_in, const int* in_sizes, int n_in, void* d_out, int out_size, void* d_ws, size_t ws_size, hipStream_t stream) {
    static int grid = 0;
    if (grid == 0) {
        int dev = 0, cus = 0, per_cu = 0;
        hipGetDevice(&dev);
        hipDeviceGetAttribute(&cus, hipDeviceAttributeMultiprocessorCount, dev);
        hipFuncSetAttribute((const void*)fwd_kernel, hipFuncAttributeMaxDynamicSharedMemorySize, LDS_BYTES);
        hipOccupancyMaxActiveBlocksPerMultiprocessor(&per_cu, (const void*)fwd_kernel, NTHREADS, LDS_BYTES);
        if (per_cu < 1) { fprintf(stderr, "kernel_launch: occupancy query says %d blocks per CU\n", per_cu); per_cu = 1; }
        (void)hipGetLastError();
        grid = cus;
        if (n_in != 32) fprintf(stderr, "kernel_launch: expected 32 inputs, got %d\n", n_in);
    }
    Args a{};
    for (int i = 0; i < 32; ++i) a.in[i] = (const float*)d_in[i];
    a.out = (float*)d_out; a.ws = (unsigned char*)d_ws;
    void* args[] = {&a};
    hipError_t e = hipLaunchCooperativeKernel((const void*)fwd_kernel, dim3(grid), dim3(NTHREADS), args, LDS_BYTES, stream);
    if (e != hipSuccess) fprintf(stderr, "cooperative launch failed: %s (grid %d)\n", hipGetErrorString(e), grid);
}
```
